# Optimizing an MI355X kernel written in HIP

```python
import jax, jax.numpy as jnp
from jax import lax
import numpy as np

D_MODEL = 2048
BATCH = 2
SEQ = 4096
DEPTH = 1

N_META = 16
POOL_WIDTH = D_MODEL
POOL_WINDOWS = (2, 4, 8, 16)
POOL_GROUPS = len(POOL_WINDOWS)
POOL_GROUP_DIM = POOL_WIDTH // POOL_GROUPS
LRU_WIDTH = D_MODEL
LRU_HEAD_DIM = 256
LRU_HEADS = LRU_WIDTH // LRU_HEAD_DIM
CONV_WIDTH = 4
LRU_C = 8.0
D_FF = 4 * D_MODEL
NORM_EPS = 1e-6
IN_SPLITS = (POOL_WIDTH,
             POOL_WIDTH + LRU_WIDTH,
             POOL_WIDTH + 2 * LRU_WIDTH,
             POOL_WIDTH + 2 * LRU_WIDTH + D_MODEL)
IN_COLS = POOL_WIDTH + 2 * LRU_WIDTH + 2 * D_MODEL

kernel_name = "hybrid_pool_rglru_gated_block"


def rmsnorm(x, g):
    xf = x.astype(jnp.float32)
    y = xf * lax.rsqrt(jnp.mean(xf * xf, axis=-1, keepdims=True) + NORM_EPS)
    return (y * g.astype(jnp.float32)).astype(x.dtype)


def causal_window_mean(v, w):
    T = v.shape[1]
    c = lax.cumsum(v, axis=1)
    c_shift = jnp.pad(c, ((0, 0), (w, 0), (0, 0)))[:, :T]
    cnt = jnp.minimum(jnp.arange(1, T + 1), w).astype(jnp.float32)
    return (c - c_shift) / cnt[None, :, None]


def pool_mixer(v, pool_w, pool_scale):
    B, T, _ = v.shape
    vf = v.astype(jnp.float32)
    diffs = []
    for g, w in enumerate(POOL_WINDOWS):
        vg = vf[..., g * POOL_GROUP_DIM:(g + 1) * POOL_GROUP_DIM]
        diffs.append(causal_window_mean(vg, w) - vg)
    d = jnp.stack(diffs, axis=2)
    y = jnp.einsum('btgc,gcd->btgd', d, pool_w.astype(jnp.float32))
    y = y.reshape(B, T, POOL_WIDTH) * pool_scale.astype(jnp.float32)
    return y.astype(v.dtype)


def causal_depthwise_conv(x, w, b):
    y = lax.conv_general_dilated(
        x, w[:, None, :].astype(x.dtype), window_strides=(1,),
        padding=((CONV_WIDTH - 1, 0),),
        dimension_numbers=('NWC', 'WIO', 'NWC'),
        feature_group_count=x.shape[-1])
    return y + b.astype(x.dtype)


def rg_lru(xc, gate_a_w, gate_a_b, gate_x_w, gate_x_b, lam):
    B, T, W = xc.shape
    xf = xc.astype(jnp.float32)
    xh = xf.reshape(B, T, LRU_HEADS, LRU_HEAD_DIM)
    r = jax.nn.sigmoid(jnp.einsum('bthi,hij->bthj', xh, gate_a_w.astype(jnp.float32))
                       + gate_a_b.astype(jnp.float32)).reshape(B, T, W)
    i = jax.nn.sigmoid(jnp.einsum('bthi,hij->bthj', xh, gate_x_w.astype(jnp.float32))
                       + gate_x_b.astype(jnp.float32)).reshape(B, T, W)
    log_a = -LRU_C * r * jax.nn.softplus(-lam.astype(jnp.float32))
    a = jnp.exp(log_a)
    mult = jnp.sqrt(-jnp.expm1(2.0 * log_a))
    bt = mult * (i * xf)

    def combine(left, right):
        a1, b1 = left
        a2, b2 = right
        return a1 * a2, a2 * b1 + b2

    _, h = lax.associative_scan(combine, (a, bt), axis=1)
    return h.astype(xc.dtype)


def setup_inputs(seed: int = 0) -> dict:
    key = jax.random.key(seed)
    ks = jax.random.split(key, 20)
    f32 = jnp.float32
    x = jax.random.normal(ks[0], (BATCH, SEQ, D_MODEL), f32)
    meta_tokens = jax.random.normal(ks[1], (N_META, D_MODEL), f32)
    norm1_g = 1.0 + 0.02 * jax.random.normal(ks[2], (DEPTH, D_MODEL), f32)
    w_in = jax.random.normal(ks[3], (DEPTH, D_MODEL, IN_COLS), f32) * D_MODEL ** -0.5
    pool_w = jax.random.normal(ks[4], (DEPTH, POOL_GROUPS, POOL_GROUP_DIM, POOL_GROUP_DIM), f32) * POOL_GROUP_DIM ** -0.5
    pool_scale = 1.0 + 0.02 * jax.random.normal(ks[5], (DEPTH, POOL_WIDTH), f32)
    conv_w = jax.random.normal(ks[6], (DEPTH, CONV_WIDTH, LRU_WIDTH), f32) * CONV_WIDTH ** -0.5
    conv_b = 0.01 * jax.random.normal(ks[7], (DEPTH, LRU_WIDTH), f32)
    gate_a_w = jax.random.normal(ks[8], (DEPTH, LRU_HEADS, LRU_HEAD_DIM, LRU_HEAD_DIM), f32) * LRU_HEAD_DIM ** -0.5
    gate_a_b = 0.01 * jax.random.normal(ks[9], (DEPTH, LRU_HEADS, LRU_HEAD_DIM), f32)
    gate_x_w = jax.random.normal(ks[10], (DEPTH, LRU_HEADS, LRU_HEAD_DIM, LRU_HEAD_DIM), f32) * LRU_HEAD_DIM ** -0.5
    gate_x_b = 0.01 * jax.random.normal(ks[11], (DEPTH, LRU_HEADS, LRU_HEAD_DIM), f32)
    u = jax.random.uniform(ks[12], (DEPTH, LRU_WIDTH), f32, minval=0.9, maxval=0.999)
    s = u ** (1.0 / LRU_C)
    lru_lambda = jnp.log(s) - jnp.log1p(-s)
    w_out = jax.random.normal(ks[13], (DEPTH, D_MODEL, D_MODEL), f32) * D_MODEL ** -0.5
    norm2_g = 1.0 + 0.02 * jax.random.normal(ks[14], (DEPTH, D_MODEL), f32)
    mlp_w1 = jax.random.normal(ks[15], (DEPTH, D_MODEL, D_FF), f32) * D_MODEL ** -0.5
    mlp_w2 = jax.random.normal(ks[16], (DEPTH, D_FF, D_MODEL), f32) * D_FF ** -0.5
    final_g = 1.0 + 0.02 * jax.random.normal(ks[17], (D_MODEL,), f32)
    return {"x": x, "meta_tokens": meta_tokens, "norm1_g": norm1_g, "w_in": w_in,
            "pool_w": pool_w, "pool_scale": pool_scale, "conv_w": conv_w, "conv_b": conv_b,
            "gate_a_w": gate_a_w, "gate_a_b": gate_a_b, "gate_x_w": gate_x_w, "gate_x_b": gate_x_b,
            "lru_lambda": lru_lambda, "w_out": w_out, "norm2_g": norm2_g,
            "mlp_w1": mlp_w1, "mlp_w2": mlp_w2, "final_g": final_g}


def reference(x, meta_tokens, norm1_g, w_in, pool_w, pool_scale, conv_w, conv_b,
              gate_a_w, gate_a_b, gate_x_w, gate_x_b, lru_lambda, w_out, norm2_g,
              mlp_w1, mlp_w2, final_g):
    B = x.shape[0]
    meta = jnp.broadcast_to(meta_tokens[None].astype(x.dtype), (B, N_META, x.shape[-1]))
    h = jnp.concatenate([meta, x], axis=1)
    for l in range(DEPTH):
        u = rmsnorm(h, norm1_g[l])
        proj = u @ w_in[l]
        v_pool, v_lru, v_gelu, g_pool, g_lru = jnp.split(proj, IN_SPLITS, axis=-1)
        pool_out = pool_mixer(v_pool, pool_w[l], pool_scale[l])
        xc = causal_depthwise_conv(v_lru, conv_w[l], conv_b[l])
        lru_out = rg_lru(xc, gate_a_w[l], gate_a_b[l], gate_x_w[l], gate_x_b[l],
                         lru_lambda[l]) * jax.nn.gelu(v_gelu)
        merged = jax.nn.sigmoid(g_pool) * pool_out + jax.nn.sigmoid(g_lru) * lru_out
        h = h + merged @ w_out[l]
        u2 = rmsnorm(h, norm2_g[l])
        h = h + jnp.square(jax.nn.relu(u2 @ mlp_w1[l])) @ mlp_w2[l]
    out = rmsnorm(h, final_g)
    return out[:, N_META:]
```

```cpp
#include <hip/hip_runtime.h>
#include <cstdio>
#include <cstdint>

#ifndef MK_N_LAUNCHES
#define MK_N_LAUNCHES 1
#endif
#ifndef MK_SIMPLE_GEMM
#define MK_SIMPLE_GEMM 0
#endif

namespace pg8 {
#define PG8_LAS __attribute__((address_space(3)))
typedef unsigned short bf16_t;
typedef short bf16x8 __attribute__((ext_vector_type(8)));
typedef float f32x4 __attribute__((ext_vector_type(4)));
typedef unsigned u32x4 __attribute__((ext_vector_type(4)));
typedef unsigned u32x2 __attribute__((ext_vector_type(2)));
constexpr int BM = 256, BK = 64, HALF = 128, HTB = HALF * BK * 2  , STAGE_BYTES = 8 * HTB, NXCD = 8, WGM = 8;

__host__ __device__ __forceinline__ int lds_byte(int r, int c) { const int st = (r >> 4) * 2 + (c >> 5), rr = r & 15, cc = c & 31, ob = rr * 64 + cc * 2; return st * 1024 + (ob ^ (((ob >> 9) & 1) << 5)); }
__host__ __device__ __forceinline__ void stage_rc(int b, int& R, int& C) { const int st = b / 1024, sb = b % 1024, swz = sb ^ (((sb >> 9) & 1) << 5); R = (st >> 1) * 16 + swz / 64; C = (st & 1) * 32 + (swz % 64) / 2; }
__host__ __device__ __forceinline__ int perm32(int rho) { const int n = rho >> 4, i = rho & 15; return 8 * (i >> 2) + 4 * n + (i & 3); }

__device__ __forceinline__ int tid_opaque() { int t = (int)threadIdx.x; asm volatile("" : "+v"(t)); return t; }
struct Unit { int pm, pn; };
struct Gemm { const bf16_t* A; const bf16_t* Bt; int lda, K, tpg; };

struct StaticOrder {
    int nM, nN, nwg, G, c;
    __host__ __device__ void init(int M, int N, int G_, int c_) { nM = M / BM; nN = N / BM; nwg = nM * nN; G = G_; c = c_; }
    __host__ __device__ bool next(int i, Unit& u) const {
        const long L = (long)i * G + c; if (L >= nwg) return false;
        int wgid = (int)L; { const int q = nwg / NXCD, r = nwg % NXCD, xcd = wgid % NXCD, off = wgid / NXCD; wgid = (xcd < r ? xcd * (q + 1) : r * (q + 1) + (xcd - r) * q) + off; }
        const int nig = WGM * nN, gid = wgid / nig, fm = gid * WGM, gsz = (nM - fm) < WGM ? (nM - fm) : WGM;
        u.pm = fm + ((wgid % nig) % gsz); u.pn = (wgid % nig) / gsz; return true;
    }
    __device__ __forceinline__ void a_ready(const Unit&) const {}
    __device__ __forceinline__ void done(const Unit&) const {}
};

__device__ __forceinline__ unsigned cvt_pk_bf16(float lo, float hi) { unsigned r; asm volatile("v_cvt_pk_bf16_f32 %0, %1, %2" : "=v"(r) : "v"(lo), "v"(hi)); return r; }

template <class Epi, class Sched, bool ALIGN_EPI = false, bool SP2 = false>
__device__ __forceinline__ void gemm_phase(PG8_LAS unsigned char* lds, const Gemm g, const Sched& S, const Epi& E) {
    const int tid = tid_opaque(), wid = __builtin_amdgcn_readfirstlane(tid >> 6), lane = tid & 63, wr = wid >> 2, wc = wid & 3, fr = lane & 15, fq = lane >> 4;
    const int K = g.K, nt = K / BK, lda = g.lda;
    unsigned voffA[2], voffB[2];
#pragma unroll
    for (int i = 0; i < 2; ++i) { int R, C; stage_rc(tid * 16 + i * 8192, R, C); const int Rb = Epi::PERM ? ((R & ~31) + perm32(R & 31)) : R;
        voffA[i] = (unsigned)(R * lda + C) * 2u; voffB[i] = (unsigned)(Rb * K + C) * 2u; }
    const size_t kstep = (size_t)(BK * 2);
    const size_t hstepA = (size_t)HALF * lda * 2, hstepB = (size_t)HALF * K * 2;
    const size_t tstepA = 2 * hstepA, tstepB = 2 * hstepB;
    const unsigned ldsw = (unsigned)wid * 1024u;
    const int aoff = lds_byte(wr * 64 + fr, fq * 8), boff = lds_byte(wc * 32 + fr, fq * 8);
#define PG8_SA(b, h) (((b) * 2 + (h)) * HTB)
#define PG8_SB(b, h) ((4 + (b) * 2 + (h)) * HTB)
#define PG8_STAGE(bufoff, gbase, voff) do { _Pragma("unroll") for (int _i = 0; _i < 2; ++_i) \
        __builtin_amdgcn_global_load_lds((const unsigned*)((const char*)(gbase) + (voff)[_i]), (PG8_LAS unsigned*)(lds + (bufoff) + ldsw + _i * 8192), 16, 0, 0); } while (0)
#define PG8_LDA(dst, b, h) do { _Pragma("unroll") for (int m = 0; m < 4; ++m) _Pragma("unroll") for (int k = 0; k < 2; ++k) dst[m][k] = *(const PG8_LAS bf16x8*)(lds + PG8_SA(b, h) + aoff + m * 2048 + k * 1024); } while (0)
#define PG8_LDB(dst, b, h) do { _Pragma("unroll") for (int n = 0; n < 2; ++n) _Pragma("unroll") for (int k = 0; k < 2; ++k) dst[n][k] = *(const PG8_LAS bf16x8*)(lds + PG8_SB(b, h) + boff + n * 2048 + k * 1024); } while (0)
#define PG8_MMA(ai, bj, At, Bt) do { __builtin_amdgcn_s_setprio(1); _Pragma("unroll") for (int m = 0; m < 4; ++m) _Pragma("unroll") for (int n = 0; n < 2; ++n) _Pragma("unroll") for (int k = 0; k < 2; ++k) \
        acc[ai][bj][m][n] = __builtin_amdgcn_mfma_f32_16x16x32_bf16(Bt[n][k], At[m][k], acc[ai][bj][m][n], 0, 0, 0); __builtin_amdgcn_s_setprio(0); } while (0)
#define PG8_WAIT_V(n) asm volatile("s_waitcnt vmcnt(" #n ")" ::: "memory")
#define PG8_WAIT_L(n) asm volatile("s_waitcnt lgkmcnt(" #n ")" ::: "memory")
#define PG8_BAR __builtin_amdgcn_s_barrier()
#define PG8_SCHED __builtin_amdgcn_sched_barrier(0)
    Unit cur, nxt; int ui = 0;
    if (!S.next(0, cur)) return;
    f32x4 acc[2][2][4][2];
#pragma unroll
    for (int a = 0; a < 2; ++a)
#pragma unroll
        for (int b = 0; b < 2; ++b)
#pragma unroll
            for (int m = 0; m < 4; ++m)
#pragma unroll
                for (int n = 0; n < 2; ++n) acc[a][b][m][n] = (f32x4){0.f, 0.f, 0.f, 0.f};
    bf16x8 At[4][2], B0[2][2], B1[2][2];
    const char* cA = (const char*)g.A + (size_t)cur.pm * tstepA + (size_t)(cur.pn / g.tpg) * K * 2; const char* cB = (const char*)g.Bt + (size_t)cur.pn * tstepB;
    S.a_ready(cur);
    if constexpr (SP2) {
        PG8_STAGE(PG8_SB(0, 0), cB, voffB); PG8_STAGE(PG8_SB(0, 1), cB + hstepB, voffB); PG8_STAGE(PG8_SA(0, 0), cA, voffA); PG8_STAGE(PG8_SA(0, 1), cA + hstepA, voffA);
        if (wr == 1) PG8_BAR;
        PG8_WAIT_V(2); PG8_BAR;
        PG8_STAGE(PG8_SB(1, 0), cB + kstep, voffB); PG8_STAGE(PG8_SA(1, 0), cA + kstep, voffA); PG8_STAGE(PG8_SB(1, 1), cB + hstepB + kstep, voffB);
        PG8_WAIT_V(6); PG8_BAR;
    } else {
        PG8_STAGE(PG8_SB(0, 0), cB, voffB); PG8_STAGE(PG8_SA(0, 0), cA, voffA); PG8_STAGE(PG8_SB(0, 1), cB + hstepB, voffB); PG8_STAGE(PG8_SA(0, 1), cA + hstepA, voffA);
        if (wr == 1) PG8_BAR;
        PG8_WAIT_V(4); PG8_BAR;
        PG8_STAGE(PG8_SB(1, 0), cB + kstep, voffB); PG8_STAGE(PG8_SA(1, 0), cA + kstep, voffA); PG8_STAGE(PG8_SB(1, 1), cB + hstepB + kstep, voffB);
        PG8_WAIT_V(6); PG8_BAR;
    }
    for (;;) {
        const bool has_next = S.next(ui + 1, nxt);
        const char* nA = has_next ? (const char*)g.A + (size_t)nxt.pm * tstepA + (size_t)(nxt.pn / g.tpg) * K * 2 : cA; const char* nB = has_next ? (const char*)g.Bt + (size_t)nxt.pn * tstepB : cB;
        for (int t = 0; t < nt; t += 2) {
            const bool last = (t == nt - 2);
            const char* a1 = cA + (size_t)(t + 1) * kstep;
            const char* a2 = last ? nA : cA + (size_t)(t + 2) * kstep; const char* b2 = last ? nB : cB + (size_t)(t + 2) * kstep;
            const char* a3 = a2 + kstep; const char* b3 = b2 + kstep;
            if (last && has_next) S.a_ready(nxt);
            if constexpr (SP2) {
            PG8_LDB(B0, 0, 0); PG8_LDB(B1, 0, 1); PG8_SCHED; PG8_LDA(At, 0, 0); PG8_STAGE(PG8_SA(1, 1), a1 + hstepA, voffA);
            PG8_WAIT_V(8); PG8_WAIT_L(0); PG8_BAR; PG8_MMA(0, 0, At, B0); PG8_MMA(0, 1, At, B1); PG8_BAR; PG8_SCHED;
            PG8_LDA(At, 0, 1); PG8_STAGE(PG8_SB(0, 0), b2, voffB); PG8_STAGE(PG8_SB(0, 1), b2 + hstepB, voffB); PG8_STAGE(PG8_SA(0, 0), a2, voffA);
            PG8_WAIT_V(8); PG8_WAIT_L(0); PG8_BAR; PG8_MMA(1, 0, At, B0); PG8_MMA(1, 1, At, B1); PG8_BAR; PG8_SCHED;
            PG8_LDB(B0, 1, 0); PG8_LDB(B1, 1, 1); PG8_SCHED; PG8_LDA(At, 1, 0); PG8_STAGE(PG8_SA(0, 1), a2 + hstepA, voffA);
            PG8_WAIT_V(8); PG8_WAIT_L(0); PG8_BAR; PG8_MMA(0, 0, At, B0); PG8_MMA(0, 1, At, B1); PG8_BAR; PG8_SCHED;
            PG8_LDA(At, 1, 1); PG8_STAGE(PG8_SB(1, 0), b3, voffB); PG8_STAGE(PG8_SB(1, 1), b3 + hstepB, voffB); PG8_STAGE(PG8_SA(1, 0), a3, voffA);
            PG8_WAIT_V(8); PG8_WAIT_L(0); PG8_BAR; PG8_MMA(1, 0, At, B0); PG8_MMA(1, 1, At, B1); PG8_BAR; PG8_SCHED;
            } else {
            PG8_LDB(B0, 0, 0); PG8_SCHED; PG8_LDA(At, 0, 0); PG8_STAGE(PG8_SA(1, 1), a1 + hstepA, voffA);
            PG8_WAIT_L(8); PG8_BAR; PG8_WAIT_L(0); PG8_MMA(0, 0, At, B0); PG8_BAR; PG8_SCHED;
            PG8_LDB(B1, 0, 1); PG8_STAGE(PG8_SB(0, 0), b2, voffB);
            PG8_BAR; PG8_WAIT_L(0); PG8_MMA(0, 1, At, B1); PG8_BAR;
            PG8_LDA(At, 0, 1); PG8_STAGE(PG8_SA(0, 0), a2, voffA);
            PG8_BAR; PG8_WAIT_L(0); PG8_MMA(1, 0, At, B0); PG8_BAR; PG8_SCHED;
            PG8_STAGE(PG8_SB(0, 1), b2 + hstepB, voffB);
            PG8_WAIT_V(6); PG8_BAR; PG8_MMA(1, 1, At, B1); PG8_BAR;
            PG8_LDB(B0, 1, 0); PG8_SCHED; PG8_LDA(At, 1, 0); PG8_STAGE(PG8_SA(0, 1), a2 + hstepA, voffA);
            PG8_WAIT_L(8); PG8_BAR; PG8_WAIT_L(0); PG8_MMA(0, 0, At, B0); PG8_BAR; PG8_SCHED;
            PG8_LDB(B1, 1, 1); PG8_STAGE(PG8_SB(1, 0), b3, voffB);
            PG8_BAR; PG8_WAIT_L(0); PG8_MMA(0, 1, At, B1); PG8_BAR;
            PG8_LDA(At, 1, 1); PG8_STAGE(PG8_SA(1, 0), a3, voffA);
            PG8_BAR; PG8_WAIT_L(0); PG8_MMA(1, 0, At, B0); PG8_BAR; PG8_SCHED;
            PG8_STAGE(PG8_SB(1, 1), b3 + hstepB, voffB);
            PG8_WAIT_V(6); PG8_BAR; PG8_MMA(1, 1, At, B1); PG8_BAR;
            }
        }
        if constexpr (ALIGN_EPI) { if (wr == 0) PG8_BAR; }
        E(acc, cur, wr, wc, fr, fq); S.done(cur);
        if (!has_next) break;
#pragma unroll
        for (int a = 0; a < 2; ++a)
#pragma unroll
            for (int b = 0; b < 2; ++b)
#pragma unroll
                for (int m = 0; m < 4; ++m)
#pragma unroll
                    for (int n = 0; n < 2; ++n) acc[a][b][m][n] = (f32x4){0.f, 0.f, 0.f, 0.f};
        cur = nxt; cA = nA; cB = nB; ++ui;
        if constexpr (ALIGN_EPI) { if (wr == 1) PG8_BAR; }
    }
    PG8_WAIT_V(0);
    if constexpr (!ALIGN_EPI) { if (wr == 0) PG8_BAR; }
    PG8_BAR;
#undef PG8_SA
#undef PG8_SB
#undef PG8_STAGE
#undef PG8_LDA
#undef PG8_LDB
#undef PG8_MMA
#undef PG8_WAIT_V
#undef PG8_WAIT_L
#undef PG8_BAR
#undef PG8_SCHED
}

template <class Epi, class Sched>
__device__ __forceinline__ void gemm_simple(const Gemm g, const Sched& S, const Epi& E) {
    const int tid = tid_opaque(), wid = __builtin_amdgcn_readfirstlane(tid >> 6), lane = tid & 63, wr = wid >> 2, wc = wid & 3, fr = lane & 15, fq = lane >> 4;
    Unit cur;
    for (int ui = 0; S.next(ui, cur); ++ui) {
        f32x4 acc[2][2][4][2];
#pragma unroll
        for (int a = 0; a < 2; ++a)
#pragma unroll
            for (int b = 0; b < 2; ++b)
#pragma unroll
                for (int m = 0; m < 4; ++m)
#pragma unroll
                    for (int n = 0; n < 2; ++n) acc[a][b][m][n] = (f32x4){0.f, 0.f, 0.f, 0.f};
        const bf16_t* Ab = g.A + (size_t)cur.pm * 256 * g.lda + (size_t)(cur.pn / g.tpg) * g.K;
        const bf16_t* Bb = g.Bt + (size_t)cur.pn * 256 * g.K;
        for (int k0 = 0; k0 < g.K; k0 += 32) {
            bf16x8 a[2][4], b[2][2];
#pragma unroll
            for (int ai = 0; ai < 2; ++ai)
#pragma unroll
                for (int m = 0; m < 4; ++m) a[ai][m] = *(const bf16x8*)(Ab + (size_t)(128 * ai + 64 * wr + 16 * m + fr) * g.lda + k0 + 8 * fq);
#pragma unroll
            for (int bj = 0; bj < 2; ++bj)
#pragma unroll
                for (int n = 0; n < 2; ++n) { const int slot = 16 * n + fr; const int rr = Epi::PERM ? perm32(slot) : slot;
                    b[bj][n] = *(const bf16x8*)(Bb + (size_t)(128 * bj + 32 * wc + rr) * g.K + k0 + 8 * fq); }
#pragma unroll
            for (int ai = 0; ai < 2; ++ai)
#pragma unroll
                for (int bj = 0; bj < 2; ++bj)
#pragma unroll
                    for (int m = 0; m < 4; ++m)
#pragma unroll
                        for (int n = 0; n < 2; ++n) acc[ai][bj][m][n] = __builtin_amdgcn_mfma_f32_16x16x32_bf16(b[bj][n], a[ai][m], acc[ai][bj][m][n], 0, 0, 0);
        }
        E(acc, cur, wr, wc, fr, fq);
    }
    __syncthreads();
}
}

constexpr int NWAVES = 8;
constexpr int N_LAUNCHES = MK_N_LAUNCHES;
constexpr int NPHASES = 10;
constexpr int D = 2048, SEQ = 4096, BATCH = 2, NMETA = 16, MR = BATCH * SEQ, INC = 5 * D, DFF = 4 * D;
constexpr int NCHUNK = MR / 64;
constexpr float NORM_EPS = 1e-6f;
constexpr int PST = 4 * D;
constexpr int COL_VPOOL = 0, COL_VLRU = D, COL_G = 2 * D, COL_SGP = 3 * D;

constexpr size_t MiB = 1u << 20;
constexpr size_t WS_CTL = 0, CTL_ZERO_BYTES = 1 * MiB;
constexpr size_t WS_ROWSS1 = 256 * 1024, WS_ROWSS2 = 320 * 1024;
constexpr size_t WS_WIN_T = 1 * MiB;
constexpr size_t WS_XCB = WS_WIN_T, WS_H1BF = WS_WIN_T;
constexpr size_t WS_WOUT_T = 41 * MiB;
constexpr size_t WS_W1_T = 49 * MiB;
constexpr size_t WS_W2_T = 81 * MiB;
constexpr size_t WS_POOL_T = 113 * MiB;
constexpr size_t WS_GATE_T = 115 * MiB;
constexpr size_t WS_PROJ = 117 * MiB;
constexpr size_t WS_ACT = WS_PROJ;
constexpr size_t WS_U = 277 * MiB;
constexpr size_t WS_SMALL = 309 * MiB;
constexpr size_t WS_UMETA = WS_SMALL;
constexpr size_t WS_PROJMETA = WS_SMALL + 64 * 1024;
constexpr size_t WS_XCMETA = WS_SMALL + 320 * 1024;
constexpr size_t WS_HMETA = WS_SMALL + 448 * 1024;
constexpr size_t WS_NLS = WS_SMALL + 456 * 1024;
constexpr size_t WS_ACH = WS_SMALL + 1 * MiB;
constexpr size_t WS_BCH = WS_SMALL + 2 * MiB;
constexpr size_t WS_CARRY = WS_SMALL + 3 * MiB;
constexpr size_t WS_END = 313 * MiB;
constexpr int CW_TMO = 0, CW_BAR = 4096;

constexpr int RING_OFF = 0, RING_BYTES = 131072;
constexpr int LDSCTL_OFF = RING_BYTES, MISC_OFF = LDSCTL_OFF + 320;
constexpr int LDS_BYTES = 147456;

#define GAS __attribute__((address_space(1)))
#define LAS __attribute__((address_space(3)))
typedef unsigned short bf16;
typedef unsigned v4u __attribute__((ext_vector_type(4)));
typedef unsigned v2u __attribute__((ext_vector_type(2)));
typedef float f32x4 __attribute__((ext_vector_type(4)));
typedef short bf16x8 __attribute__((ext_vector_type(8)));
typedef GAS unsigned gu32;
#define RLX_AGENT __ATOMIC_RELAXED, __HIP_MEMORY_SCOPE_AGENT
#define LDS_WAIT() asm volatile("s_waitcnt lgkmcnt(0)" ::: "memory")
#define VM_WAIT() asm volatile("s_waitcnt vmcnt(0)" ::: "memory")
__device__ __forceinline__ unsigned f2bf(float f) { unsigned u = __builtin_bit_cast(unsigned, f); return (u + 0x7fffu + ((u >> 16) & 1u)) >> 16; }
__device__ __forceinline__ unsigned pk2(float lo, float hi) { return f2bf(lo) | (f2bf(hi) << 16); }
__device__ __forceinline__ float bflo(unsigned w) { return __builtin_bit_cast(float, w << 16); }
__device__ __forceinline__ float bfhi(unsigned w) { return __builtin_bit_cast(float, w & 0xffff0000u); }
__device__ __forceinline__ void unpack8(v4u w, float (&f)[8]) { f[0] = bflo(w.x); f[1] = bfhi(w.x); f[2] = bflo(w.y); f[3] = bfhi(w.y); f[4] = bflo(w.z); f[5] = bfhi(w.z); f[6] = bflo(w.w); f[7] = bfhi(w.w); }
__device__ __forceinline__ v4u pack8(const float (&f)[8]) { v4u w; w.x = pg8::cvt_pk_bf16(f[0], f[1]); w.y = pg8::cvt_pk_bf16(f[2], f[3]); w.z = pg8::cvt_pk_bf16(f[4], f[5]); w.w = pg8::cvt_pk_bf16(f[6], f[7]); return w; }
__device__ __forceinline__ float sigm(float z) { return __builtin_amdgcn_rcpf(1.f + __builtin_amdgcn_exp2f(-1.4426950408889634f * z)); }
__device__ __forceinline__ float expm1_neg(float x) {
    float p = 1.f / 5040.f; p = p * x + 1.f / 720.f; p = p * x + 1.f / 120.f; p = p * x + 1.f / 24.f; p = p * x + 1.f / 6.f; p = p * x + 0.5f; p = p * x + 1.f; p = p * x;
    const float q = __builtin_amdgcn_exp2f(1.4426950408889634f * x) - 1.f;
    return x > -0.25f ? p : q;
}
__device__ __forceinline__ float gelu_tanh(float x) { return x * sigm(1.5957691216057308f * (x + 0.044715f * x * x * x)); }
template <int S> __device__ __forceinline__ float dpp_shr(float oldv, float src) {
    return __builtin_bit_cast(float, __builtin_amdgcn_update_dpp(__builtin_bit_cast(int, oldv), __builtin_bit_cast(int, src), 0x110 + S, 0xf, 0xf, false));
}

typedef f32x4 AccT[2][2][4][2];
struct EpiProj {
    static constexpr bool PERM = true;
    bf16* O;
    __device__ __forceinline__ void operator()(AccT& acc, const pg8::Unit& u, int wr, int wc, int fr, int fq) const {
        const int row0 = u.pm * 256 + wr * 64 + fr;
        if (u.pn >= 16 && u.pn < 32) {
            const int col0 = COL_G + (u.pn - 16) * 128 + wc * 32 + 8 * fq;
#pragma unroll
            for (int ai = 0; ai < 2; ++ai)
#pragma unroll
                for (int m = 0; m < 4; ++m) { float o[8];
#pragma unroll
                    for (int e = 0; e < 8; ++e) o[e] = sigm(acc[ai][1][m][e >> 2][e & 3]) * gelu_tanh(acc[ai][0][m][e >> 2][e & 3]);
                    *(v4u*)(O + (size_t)(row0 + ai * 128 + m * 16) * PST + col0) = pack8(o); }
        } else {
            const bool sg = u.pn >= 32; const int col0 = (sg ? COL_SGP + (u.pn - 32) * 256 : u.pn * 256) + wc * 32 + 8 * fq;
#pragma unroll
            for (int ai = 0; ai < 2; ++ai)
#pragma unroll
                for (int m = 0; m < 4; ++m) { bf16* rowp = O + (size_t)(row0 + ai * 128 + m * 16) * PST + col0;
#pragma unroll
                    for (int bj = 0; bj < 2; ++bj) { float o[8];
#pragma unroll
                        for (int e = 0; e < 8; ++e) { const float v = acc[ai][bj][m][e >> 2][e & 3]; o[e] = sg ? sigm(v) : v; }
                        *(v4u*)(rowp + bj * 128) = pack8(o); } }
        }
    }
};
struct EpiPool {
    static constexpr bool PERM = true;
    bf16* proj; const float* pscale;
    __device__ __forceinline__ void operator()(AccT& acc, const pg8::Unit& u, int wr, int wc, int fr, int fq) const {
        const int row0 = u.pm * 256 + wr * 64 + fr, ch0 = u.pn * 256 + wc * 32 + 8 * fq;
        float ps[2][8];
#pragma unroll
        for (int bj = 0; bj < 2; ++bj) { const f32x4 a = *(const f32x4*)(pscale + ch0 + 128 * bj), b = *(const f32x4*)(pscale + ch0 + 128 * bj + 4);
#pragma unroll
            for (int e = 0; e < 4; ++e) { ps[bj][e] = a[e]; ps[bj][4 + e] = b[e]; } }
#pragma unroll
        for (int ai = 0; ai < 2; ++ai)
#pragma unroll
            for (int m = 0; m < 4; ++m) { bf16* rowp = proj + (size_t)(row0 + ai * 128 + m * 16) * PST + COL_SGP + ch0;
#pragma unroll
                for (int bj = 0; bj < 2; ++bj) { float gp[8], o[8]; unpack8(*(const v4u*)(rowp + 128 * bj), gp);
#pragma unroll
                    for (int e = 0; e < 8; ++e) o[e] = gp[e] * acc[ai][bj][m][e >> 2][e & 3] * ps[bj][e];
                    *(v4u*)(rowp + 128 * bj) = pack8(o); } }
    }
};
struct EpiGate {
    static constexpr bool PERM = true;
    bf16* proj; const bf16* xcb; const float* ba; const float* bx; const float* nls; float* ach; float* bch;
    __device__ __forceinline__ void operator()(AccT& acc, const pg8::Unit& u, int wr, int wc, int fr, int fq) const {
        const int row0 = u.pm * 256 + wr * 64 + fr, ch0 = u.pn * 128 + wc * 32 + 8 * fq;
        float cba[8], cbx[8], cnl[8];
        { const f32x4 a0 = *(const f32x4*)(ba + ch0), a1 = *(const f32x4*)(ba + ch0 + 4), b0 = *(const f32x4*)(bx + ch0), b1 = *(const f32x4*)(bx + ch0 + 4), c0 = *(const f32x4*)(nls + ch0), c1 = *(const f32x4*)(nls + ch0 + 4);
#pragma unroll
          for (int e = 0; e < 4; ++e) { cba[e] = a0[e]; cba[4 + e] = a1[e]; cbx[e] = b0[e]; cbx[4 + e] = b1[e]; cnl[e] = c0[e]; cnl[4 + e] = c1[e]; } }
        const int lane15 = (pg8::tid_opaque() & 63) | 15;
#pragma unroll
        for (int ai = 0; ai < 2; ++ai)
#pragma unroll
            for (int m = 0; m < 4; ++m) { float xc[8]; unpack8(*(const v4u*)(xcb + (size_t)(row0 + ai * 128 + m * 16) * D + ch0), xc);
#pragma unroll
                for (int e = 0; e < 8; ++e) { const float r = sigm(acc[ai][0][m][e >> 2][e & 3] + cba[e]), ig = sigm(acc[ai][1][m][e >> 2][e & 3] + cbx[e]);
                    const float t = expm1_neg(cnl[e] * r);
                    acc[ai][0][m][e >> 2][e & 3] = 1.f + t; acc[ai][1][m][e >> 2][e & 3] = __builtin_amdgcn_sqrtf(-t * (2.f + t)) * ig * xc[e]; }
                asm volatile("" ::: "memory"); __builtin_amdgcn_sched_barrier(0); }
#pragma unroll
        for (int ai = 0; ai < 2; ++ai) {
#pragma unroll
            for (int m = 0; m < 4; ++m)
#pragma unroll
                for (int e = 0; e < 8; ++e) { float A = acc[ai][0][m][e >> 2][e & 3], B = acc[ai][1][m][e >> 2][e & 3], As, Bs;
                    As = dpp_shr<1>(1.f, A); Bs = dpp_shr<1>(0.f, B); B = A * Bs + B; A = A * As;
                    As = dpp_shr<2>(1.f, A); Bs = dpp_shr<2>(0.f, B); B = A * Bs + B; A = A * As;
                    As = dpp_shr<4>(1.f, A); Bs = dpp_shr<4>(0.f, B); B = A * Bs + B; A = A * As;
                    As = dpp_shr<8>(1.f, A); Bs = dpp_shr<8>(0.f, B); B = A * Bs + B; A = A * As;
                    acc[ai][0][m][e >> 2][e & 3] = A; acc[ai][1][m][e >> 2][e & 3] = B; if (e == 7) __builtin_amdgcn_sched_barrier(0); }
#pragma unroll
            for (int m = 1; m < 4; ++m)
#pragma unroll
                for (int e = 0; e < 8; ++e) { const float CA = __shfl(acc[ai][0][m - 1][e >> 2][e & 3], lane15), CB = __shfl(acc[ai][1][m - 1][e >> 2][e & 3], lane15);
                    const float A = acc[ai][0][m][e >> 2][e & 3], B = acc[ai][1][m][e >> 2][e & 3];
                    acc[ai][1][m][e >> 2][e & 3] = A * CB + B; acc[ai][0][m][e >> 2][e & 3] = A * CA; }
#pragma unroll
            for (int m = 0; m < 4; ++m) { bf16* rowp = proj + (size_t)(row0 + ai * 128 + m * 16) * PST + ch0; float gg[8], oh[8], oa[8];
                unpack8(*(const v4u*)(rowp + COL_G), gg);
#pragma unroll
                for (int e = 0; e < 8; ++e) { oh[e] = gg[e] * acc[ai][1][m][e >> 2][e & 3]; oa[e] = gg[e] * acc[ai][0][m][e >> 2][e & 3]; }
                *(v4u*)(rowp + COL_VLRU) = pack8(oh); *(v4u*)(rowp + COL_G) = pack8(oa);
                asm volatile("" ::: "memory"); __builtin_amdgcn_sched_barrier(0); }
            if (fr == 15) { const int chunk = u.pm * 4 + 2 * ai + wr; float* pa = ach + (size_t)chunk * D + ch0; float* pb = bch + (size_t)chunk * D + ch0;
                *(f32x4*)pa = acc[ai][0][3][0]; *(f32x4*)(pa + 4) = acc[ai][0][3][1]; *(f32x4*)pb = acc[ai][1][3][0]; *(f32x4*)(pb + 4) = acc[ai][1][3][1]; }
        }
    }
};
struct EpiH1 {
    static constexpr bool PERM = false;
    const float* x; float* out; bf16* h1bf; float* rowss;
    __device__ __forceinline__ void operator()(AccT& acc, const pg8::Unit& u, int wr, int wc, int fr, int fq) const {
        const int row0 = u.pm * 256 + wr * 64 + fr, col0 = u.pn * 256 + wc * 32 + 4 * fq;
#pragma unroll
        for (int ai = 0; ai < 2; ++ai)
#pragma unroll
            for (int m = 0; m < 4; ++m) { const int row = row0 + ai * 128 + m * 16; const size_t off = (size_t)row * D + col0; float ss = 0.f;
#pragma unroll
                for (int bj = 0; bj < 2; ++bj)
#pragma unroll
                    for (int n = 0; n < 2; ++n) { const f32x4 h = *(const f32x4*)(x + off + bj * 128 + n * 16) + acc[ai][bj][m][n];
                        *(f32x4*)(out + off + bj * 128 + n * 16) = h; ss += (h[0] * h[0] + h[1] * h[1]) + (h[2] * h[2] + h[3] * h[3]);
                        v2u w; w.x = pg8::cvt_pk_bf16(h[0], h[1]); w.y = pg8::cvt_pk_bf16(h[2], h[3]); *(v2u*)(h1bf + off + bj * 128 + n * 16) = w; }
                ss += __shfl_xor(ss, 16); ss += __shfl_xor(ss, 32);
                if (fq == 0) atomicAdd(rowss + row, ss); }
    }
};
struct EpiAct {
    static constexpr bool PERM = true;
    bf16* O; const float* rowss;
    __device__ __forceinline__ void operator()(AccT& acc, const pg8::Unit& u, int wr, int wc, int fr, int fq) const {
        const int row0 = u.pm * 256 + wr * 64 + fr, col0 = u.pn * 256 + wc * 32 + 8 * fq;
#pragma unroll
        for (int ai = 0; ai < 2; ++ai)
#pragma unroll
            for (int m = 0; m < 4; ++m) { const int row = row0 + ai * 128 + m * 16; const float rs = rsqrtf(rowss[row] * (1.f / D) + NORM_EPS); bf16* rowp = O + (size_t)row * DFF + col0;
#pragma unroll
                for (int bj = 0; bj < 2; ++bj) { float o[8];
#pragma unroll
                    for (int e = 0; e < 8; ++e) { const float v = fmaxf(rs * acc[ai][bj][m][e >> 2][e & 3], 0.f); o[e] = v * v; }
                    *(v4u*)(rowp + bj * 128) = pack8(o); } }
    }
};
struct EpiOut {
    static constexpr bool PERM = false;
    float* out; float* rowss;
    __device__ __forceinline__ void operator()(AccT& acc, const pg8::Unit& u, int wr, int wc, int fr, int fq) const {
        const int row0 = u.pm * 256 + wr * 64 + fr, col0 = u.pn * 256 + wc * 32 + 4 * fq;
#pragma unroll
        for (int ai = 0; ai < 2; ++ai)
#pragma unroll
            for (int m = 0; m < 4; ++m) { const int row = row0 + ai * 128 + m * 16; const size_t off = (size_t)row * D + col0; float ss = 0.f;
#pragma unroll
                for (int bj = 0; bj < 2; ++bj)
#pragma unroll
                    for (int n = 0; n < 2; ++n) { const f32x4 h = *(const f32x4*)(out + off + bj * 128 + n * 16) + acc[ai][bj][m][n];
                        *(f32x4*)(out + off + bj * 128 + n * 16) = h; ss += (h[0] * h[0] + h[1] * h[1]) + (h[2] * h[2] + h[3] * h[3]); }
                ss += __shfl_xor(ss, 16); ss += __shfl_xor(ss, 32);
                if (fq == 0) atomicAdd(rowss + row, ss); }
    }
};

#define XB_TMO      128
#define XB_XCNT(j)  (256  + 64 * (j))
#define XB_XSUB(j)  (1280 + 64 * (j))
#define XB_XGEN(j)  (2304 + 64 * (j))
#define XB_TOP      3328
#define XB_TOPGEN   3392
#define XCD_BAR_WORDS 3456
#define XB_SPIN_CAP (1u << 18)
__device__ __forceinline__ unsigned xb_ld(unsigned* p)              { return __hip_atomic_load(p, __ATOMIC_RELAXED, __HIP_MEMORY_SCOPE_AGENT); }
__device__ __forceinline__ unsigned xb_add(unsigned* p, unsigned v) { return __hip_atomic_fetch_add(p, v, __ATOMIC_RELAXED, __HIP_MEMORY_SCOPE_AGENT); }
__device__ __forceinline__ unsigned xb_xcc_id() { return (unsigned)__builtin_amdgcn_s_getreg((3 << 11) | 20) & 0xFu; }
#define XB_SPIN(cond, bar) do { unsigned _sp = 0; while (cond) { __builtin_amdgcn_s_sleep(1); \
    if ((++_sp & 255u) == 0u) { if (xb_ld(&(bar)[XB_TMO])) break; if (_sp > XB_SPIN_CAP) { atomicAdd(&(bar)[XB_TMO], 1u); break; } } } } while (0)
struct XcdBarrier { unsigned* bar; unsigned x; volatile LAS unsigned* st; };
__device__ __forceinline__ XcdBarrier xcd_barrier_post(unsigned* bar, volatile LAS unsigned* st) {
    XcdBarrier b; b.bar = bar; b.x = xb_xcc_id(); b.st = st;
    if (threadIdx.x == 0) (void)xb_add(&bar[XB_XCNT(b.x)], 1u);
    return b;
}
__device__ __forceinline__ void xcd_barrier_complete(unsigned* bar, unsigned x, unsigned& nloc, unsigned& nx) {
    const unsigned G = gridDim.x * gridDim.y * gridDim.z;
    unsigned sum, cnt, mine, sp = 0u;
    for (;;) {
        sum = 0u; cnt = 0u; mine = 0u;
#pragma unroll
        for (unsigned j = 0; j < 16; ++j) { const unsigned c = xb_ld(&bar[XB_XCNT(j)]); sum += c; cnt += (c > 0u) ? 1u : 0u; mine = (j == x) ? c : mine; }
        if (sum == G) break;
        __builtin_amdgcn_s_sleep(1);
        if ((++sp & 255u) == 0u) { if (xb_ld(&bar[XB_TMO])) break; if (sp > XB_SPIN_CAP) { atomicAdd(&bar[XB_TMO], 1u); break; } }
    }
    nloc = mine > 0u ? mine : 1u; nx = cnt > 0u ? cnt : 1u;
}
__device__ __forceinline__ void xcd_barrier(const XcdBarrier& b) {
    asm volatile("s_waitcnt vmcnt(0)" ::: "memory");
    __syncthreads();
    if (threadIdx.x == 0) {
        unsigned* bar = b.bar;
        __builtin_amdgcn_s_waitcnt(0);
        unsigned nloc = b.st[0], nx = b.st[1];
        if (nloc == 0u) { xcd_barrier_complete(bar, b.x, nloc, nx); b.st[0] = nloc; b.st[1] = nx; }
        const unsigned old = xb_add(&bar[XB_XSUB(b.x)], 1u);
        const unsigned gen = old / nloc;
        if (old + 1u == (gen + 1u) * nloc) {
            __builtin_amdgcn_fence(__ATOMIC_RELEASE, "agent");
            asm volatile("s_waitcnt vmcnt(0)" ::: "memory");
            const unsigned og = xb_add(&bar[XB_TOP], 1u);
            const unsigned tg = og / nx;
            if (og + 1u == (tg + 1u) * nx) xb_add(&bar[XB_TOPGEN], 1u);
            else XB_SPIN(xb_ld(&bar[XB_TOPGEN]) == tg, bar);
            __builtin_amdgcn_fence(__ATOMIC_ACQUIRE, "agent");
            xb_add(&bar[XB_XGEN(b.x)], 1u);
            asm volatile("s_waitcnt vmcnt(0)" ::: "memory");
        } else {
            XB_SPIN(xb_ld(&bar[XB_XGEN(b.x)]) == gen, bar);
            __builtin_amdgcn_fence(__ATOMIC_ACQUIRE, "agent");
            asm volatile("s_waitcnt vmcnt(0)" ::: "memory");
        }
    }
    __syncthreads();
}

__device__ __forceinline__ float wave_sum(float v) {
#pragma unroll
    for (int o = 1; o < 64; o <<= 1) v += __shfl_xor(v, o);
    return v;
}
__device__ __forceinline__ void p0_tr_item(const float* W, int ldw, int k0, int n0, bf16* WT, int ldt, int dst_row0, const float* scale, LAS float* scr, int lane) {
#pragma unroll 8
    for (int i = 0; i < 32; ++i) { const int kk = 2 * i + (lane >> 5); float v = W[(size_t)(k0 + kk) * ldw + n0 + (lane & 31)]; if (scale) v *= scale[k0 + kk]; scr[kk * 33 + (lane & 31)] = v; }
    LDS_WAIT(); asm volatile("" ::: "memory");
    const int c = lane & 7;
#pragma unroll
    for (int j = 0; j < 4; ++j) { const int n = (lane >> 3) + 8 * j; const LAS float* s = scr + (8 * c) * 33 + n;
        v4u o; o.x = pk2(s[0 * 33], s[1 * 33]); o.y = pk2(s[2 * 33], s[3 * 33]); o.z = pk2(s[4 * 33], s[5 * 33]); o.w = pk2(s[6 * 33], s[7 * 33]);
        *(v4u*)(WT + (size_t)(dst_row0 + n) * ldt + k0 + 8 * c) = o; }
    LDS_WAIT(); asm volatile("" ::: "memory");
}
__device__ __forceinline__ void rms_row_to_bf16(const float* xrow, const float* g, bf16* orow, int lane) {
    const f32x4* xr = (const f32x4*)xrow + lane; const f32x4* gr = (const f32x4*)g + lane;
    f32x4 v[8]; float s = 0.f;
#pragma unroll
    for (int j = 0; j < 8; ++j) { v[j] = xr[64 * j]; s += (v[j][0] * v[j][0] + v[j][1] * v[j][1]) + (v[j][2] * v[j][2] + v[j][3] * v[j][3]); }
    const float rs = rsqrtf(wave_sum(s) * (1.f / D) + NORM_EPS);
    v2u* o8 = (v2u*)orow + lane;
#pragma unroll
    for (int j = 0; j < 8; ++j) { const f32x4 gg = gr[64 * j]; v2u w; w.x = pk2(v[j][0] * rs * gg[0], v[j][1] * rs * gg[1]); w.y = pk2(v[j][2] * rs * gg[2], v[j][3] * rs * gg[3]); o8[64 * j] = w; }
}
__device__ __forceinline__ void load_row8(const bf16* proj, const float* pmeta, int b, int tpos, int cg, int c0, float (&f)[8]) {
    if (tpos >= 0) unpack8(*(const v4u*)(proj + (size_t)(b * SEQ + tpos) * PST + cg * D + c0), f);
    else { const float* p = pmeta + (size_t)(NMETA + tpos) * (2 * D) + cg * D + c0; const f32x4 a = *(const f32x4*)p, c = *(const f32x4*)(p + 4);
#pragma unroll
        for (int e = 0; e < 4; ++e) { f[e] = a[e]; f[4 + e] = c[e]; } }
}

struct Args { const float* in[18]; float* out; unsigned char* ws; int ph_lo, ph_hi, li, pad; };
__global__ void __launch_bounds__(NWAVES * 64, 2) fwd_kernel(Args args) {
    extern __shared__ __attribute__((aligned(16))) unsigned char lds_raw[];
    LAS unsigned char* lds = (LAS unsigned char*)lds_raw;
    volatile LAS unsigned* MISC = (volatile LAS unsigned*)(lds + MISC_OFF);
#define tid (pg8::tid_opaque())
#define lane (pg8::tid_opaque() & 63)
#define wave (__builtin_amdgcn_readfirstlane(pg8::tid_opaque() >> 6))
    const int G = gridDim.x; const int bx = blockIdx.x; const int vcu = (G % 8 == 0) ? (bx % 8) * (G / 8) + bx / 8 : bx;
    unsigned char* ws = args.ws;
    gu32* ctl = (gu32*)(ws + WS_CTL);
    const float* x = args.in[0]; const float* meta = args.in[1]; const float* norm1_g = args.in[2]; const float* w_in = args.in[3];
    const float* pool_w = args.in[4]; const float* pool_scale = args.in[5]; const float* conv_w = args.in[6]; const float* conv_b = args.in[7];
    const float* gate_a_w = args.in[8]; const float* gate_a_b = args.in[9]; const float* gate_x_w = args.in[10]; const float* gate_x_b = args.in[11];
    const float* lru_lambda = args.in[12]; const float* w_out = args.in[13]; const float* norm2_g = args.in[14]; const float* mlp_w1 = args.in[15];
    const float* mlp_w2 = args.in[16]; const float* final_g = args.in[17];
    float* out = args.out;
    bf16* WIN_T = (bf16*)(ws + WS_WIN_T); bf16* WOUT_T = (bf16*)(ws + WS_WOUT_T); bf16* W1_T = (bf16*)(ws + WS_W1_T); bf16* W2_T = (bf16*)(ws + WS_W2_T);
    bf16* POOL_T = (bf16*)(ws + WS_POOL_T); bf16* GATE_T = (bf16*)(ws + WS_GATE_T);
    bf16* PROJ = (bf16*)(ws + WS_PROJ); bf16* ACT = (bf16*)(ws + WS_ACT); bf16* U = (bf16*)(ws + WS_U); bf16* DBUF = U; bf16* MERGED = U;
    bf16* XCB = (bf16*)(ws + WS_XCB); bf16* H1BF = (bf16*)(ws + WS_H1BF); bf16* UMETA = (bf16*)(ws + WS_UMETA);
    float* PROJMETA = (float*)(ws + WS_PROJMETA); float* XCMETA = (float*)(ws + WS_XCMETA); float* HMETA = (float*)(ws + WS_HMETA); float* NLS = (float*)(ws + WS_NLS);
    float* ACH = (float*)(ws + WS_ACH); float* BCH = (float*)(ws + WS_BCH); float* CARRY = (float*)(ws + WS_CARRY);
    float* ROWSS1 = (float*)(ws + WS_ROWSS1); float* ROWSS2 = (float*)(ws + WS_ROWSS2);

    for (int u = tid; u < (LDS_BYTES - LDSCTL_OFF) / 4; u += NWAVES * 64) ((LAS unsigned*)(lds + LDSCTL_OFF))[u] = 0u;
    __syncthreads();
    XcdBarrier bar; bar.bar = (unsigned*)(ctl + CW_BAR); bar.x = 0; bar.st = nullptr;
    if (N_LAUNCHES == 1) bar = xcd_barrier_post((unsigned*)(ctl + CW_BAR), MISC + 8);
#define GRID_BAR() do { if (N_LAUNCHES == 1) xcd_barrier(bar); } while (0)
    const int lo = args.ph_lo, hi = args.ph_hi;
#ifndef MK_PHASE_MASK
#define MK_PHASE_MASK 0x3ff
#endif
#define IN(k) (((MK_PHASE_MASK >> (k)) & 1) && lo <= (k) && (k) < hi)
#define BOTH(k) (IN(k) && IN((k) + 1))
#if MK_SIMPLE_GEMM
#define RUN_GEMM(EpiT, g, S, E) pg8::gemm_simple<EpiT, pg8::StaticOrder>(g, S, E)
#else
#define RUN_GEMM(EpiT, g, S, E) pg8::gemm_phase<EpiT, pg8::StaticOrder, true, true>(lds + RING_OFF, g, S, E)
#endif

    if (IN(0)) {
        LAS float* scr = (LAS float*)(lds + RING_OFF + wave * 16384);
        const int gw = vcu * NWAVES + wave, NGW = G * NWAVES;
        constexpr int I_IN = 32 * 320, I_OUT = 32 * 64, I_1 = 32 * 256, I_2 = 128 * 64, I_P = 4 * 8 * 16, I_G = 2 * 8 * 4 * 8;
        constexpr int NITEMS = I_IN + I_OUT + I_1 + I_2 + I_P + I_G;
        for (int it = gw; it < NITEMS; it += NGW) {
            int r = it;
            if (r < I_IN) { const int kb = r / 320, nb = r % 320, n0 = 32 * nb; int dr = n0;
                if (n0 >= 4 * D) { const int ch = n0 - 4 * D; dr = 256 * (16 + (ch >> 7)) + 128 + (ch & 127); }
                else if (n0 >= 3 * D) dr = 4 * D + (n0 - 3 * D);
                else if (n0 >= 2 * D) { const int ch = n0 - 2 * D; dr = 256 * (16 + (ch >> 7)) + (ch & 127); }
                p0_tr_item(w_in, INC, 64 * kb, n0, WIN_T, D, dr, nullptr, scr, lane); continue; } r -= I_IN;
            if (r < I_OUT) { const int kb = r / 64, nb = r % 64; p0_tr_item(w_out, D, 64 * kb, 32 * nb, WOUT_T, D, 32 * nb, nullptr, scr, lane); continue; } r -= I_OUT;
            if (r < I_1) { const int kb = r / 256, nb = r % 256; p0_tr_item(mlp_w1, DFF, 64 * kb, 32 * nb, W1_T, D, 32 * nb, norm2_g, scr, lane); continue; } r -= I_1;
            if (r < I_2) { const int kb = r / 64, nb = r % 64; p0_tr_item(mlp_w2, D, 64 * kb, 32 * nb, W2_T, DFF, 32 * nb, nullptr, scr, lane); continue; } r -= I_2;
            if (r < I_P) { const int g = r / 128, q = r % 128, kb = q / 16, nb = q % 16; p0_tr_item(pool_w + (size_t)g * 512 * 512, 512, 64 * kb, 32 * nb, POOL_T, 512, 512 * g + 32 * nb, nullptr, scr, lane); continue; } r -= I_P;
            { const int gate = r / 256, q = r % 256, h = q / 32, q2 = q % 32, kb = q2 / 8, nb = q2 % 8, j0 = 32 * nb;
              p0_tr_item((gate ? gate_x_w : gate_a_w) + (size_t)h * 65536, 256, 64 * kb, j0, GATE_T, 256, 256 * (2 * h + (j0 >> 7)) + 128 * gate + (j0 & 127), nullptr, scr, lane); }
        }
        for (int m = gw; m < MR + NMETA; m += NGW) {
            if (m < MR) rms_row_to_bf16(x + (size_t)m * D, norm1_g, U + (size_t)m * D, lane);
            else rms_row_to_bf16(meta + (size_t)(m - MR) * D, norm1_g, UMETA + (size_t)(m - MR) * D, lane);
        }
        if (bx == 0) for (int c = tid; c < D; c += NWAVES * 64) NLS[c] = -8.f * log1pf(expf(-lru_lambda[c]));
        if (BOTH(0)) GRID_BAR();
    }

    if (IN(1)) {
        { pg8::Gemm g{U, WIN_T, D, D, 1 << 30}; pg8::StaticOrder S; S.init(MR, INC, G, bx); EpiProj E{PROJ};
          RUN_GEMM(EpiProj, g, S, E); }
        __syncthreads();
        for (int nb = bx; nb < 256; nb += G) {
            const int fr = lane & 15, fq = lane >> 4, n0 = 16 * nb;
            f32x4 acc = (f32x4){0.f, 0.f, 0.f, 0.f};
#pragma unroll
            for (int kk = 0; kk < 8; ++kk) { const int k = 256 * wave + 32 * kk + 8 * fq;
                const bf16x8 a = *(const bf16x8*)(UMETA + (size_t)fr * D + k), b = *(const bf16x8*)(WIN_T + (size_t)(n0 + fr) * D + k);
                acc = __builtin_amdgcn_mfma_f32_16x16x32_bf16(a, b, acc, 0, 0, 0); }
            LAS f32x4* red = (LAS f32x4*)(lds + RING_OFF);
            red[wave * 64 + lane] = acc;
            __syncthreads();
            if (wave == 0) { f32x4 s = red[lane];
#pragma unroll
                for (int w = 1; w < 8; ++w) s += red[w * 64 + lane];
#pragma unroll
                for (int r = 0; r < 4; ++r) PROJMETA[(size_t)(4 * fq + r) * (2 * D) + n0 + fr] = s[r]; }
            __syncthreads();
        }
        if (BOTH(1)) GRID_BAR();
    }

    if (IN(2)) {
        for (int it = bx; it < 513; it += G) {
            if (it < 512) {
                const int g = wave & 3, w = 2 << g, c0 = 512 * g + 8 * lane, tbase = it * 16 + (wave >> 2) * 8;
                float cw[4][8], cb[8];
#pragma unroll
                for (int k = 0; k < 4; ++k) { const f32x4 a = *(const f32x4*)(conv_w + k * D + c0), b = *(const f32x4*)(conv_w + k * D + c0 + 4);
#pragma unroll
                    for (int e = 0; e < 4; ++e) { cw[k][e] = a[e]; cw[k][4 + e] = b[e]; } }
                { const f32x4 a = *(const f32x4*)(conv_b + c0), b = *(const f32x4*)(conv_b + c0 + 4);
#pragma unroll
                  for (int e = 0; e < 4; ++e) { cb[e] = a[e]; cb[4 + e] = b[e]; } }
                const float inv_w = 1.f / (float)w;
                for (int tt = 0; tt < 8; ++tt) {
                    const int m = tbase + tt, b = m >> 12, t = m & (SEQ - 1);
                    float s[8], cur[8], f[8];
                    load_row8(PROJ, PROJMETA, b, t, 0, c0, cur);
#pragma unroll
                    for (int e = 0; e < 8; ++e) s[e] = cur[e];
                    for (int j = 1; j < w; ++j) { load_row8(PROJ, PROJMETA, b, t - j, 0, c0, f);
#pragma unroll
                        for (int e = 0; e < 8; ++e) s[e] += f[e]; }
#pragma unroll
                    for (int e = 0; e < 8; ++e) s[e] = s[e] * inv_w - cur[e];
                    *(v4u*)(DBUF + (size_t)m * D + c0) = pack8(s);
#pragma unroll
                    for (int e = 0; e < 8; ++e) s[e] = cb[e];
#pragma unroll
                    for (int k = 0; k < 4; ++k) { load_row8(PROJ, PROJMETA, b, t - 3 + k, 1, c0, f);
#pragma unroll
                        for (int e = 0; e < 8; ++e) s[e] += cw[k][e] * f[e]; }
                    *(v4u*)(XCB + (size_t)m * D + c0) = pack8(s);
                }
            } else {
                for (int i = tid; i < NMETA * D; i += NWAVES * 64) { const int p = i >> 11, c = i & (D - 1); float s = conv_b[c];
                    for (int k = 0; k < 4; ++k) { const int q = p - 3 + k; if (q >= 0) s += conv_w[k * D + c] * PROJMETA[(size_t)q * (2 * D) + D + c]; }
                    XCMETA[i] = s; }
            }
        }
        if (BOTH(2)) GRID_BAR();
    }

    if (IN(3)) {
#ifndef MK_P3_MASK
#define MK_P3_MASK 7
#endif
        if (MK_P3_MASK & 1) { pg8::Gemm g{DBUF, POOL_T, D, 512, 2}; pg8::StaticOrder S; S.init(MR, D, G, bx); EpiPool E{PROJ, pool_scale};
          RUN_GEMM(EpiPool, g, S, E); }
        if (MK_P3_MASK & 2) { int kg = 256; asm volatile("" : "+s"(kg));
          pg8::Gemm g{XCB, GATE_T, D, kg, 2}; pg8::StaticOrder S; S.init(MR, 2 * D, G, bx); EpiGate E{PROJ, XCB, gate_a_b, gate_x_b, NLS, ACH, BCH};
          RUN_GEMM(EpiGate, g, S, E); }
        __syncthreads();
        if (MK_P3_MASK & 4) for (int h = bx; h < 8; h += G) {
            LAS float* xs = (LAS float*)(lds + RING_OFF);
            LAS float* rg = (LAS float*)(lds + RING_OFF + 16384);
            for (int i = tid; i < 16 * 256; i += NWAVES * 64) xs[i] = XCMETA[(size_t)(i >> 8) * D + 256 * h + (i & 255)];
            __syncthreads();
            const int j = tid & 255, gate = tid >> 8;
            const float* W = (gate ? gate_x_w : gate_a_w) + (size_t)h * 65536;
            const float bias = (gate ? gate_x_b : gate_a_b)[256 * h + j];
            float a16[16];
#pragma unroll
            for (int p = 0; p < 16; ++p) a16[p] = bias;
            for (int i = 0; i < 256; ++i) { const float wv = W[i * 256 + j];
#pragma unroll
                for (int p = 0; p < 16; ++p) a16[p] += xs[p * 256 + i] * wv; }
#pragma unroll
            for (int p = 0; p < 16; ++p) rg[(gate * 16 + p) * 256 + j] = sigm(a16[p]);
            __syncthreads();
            if (tid < 256) { const int ch = 256 * h + tid; const float nl = NLS[ch]; float hh = 0.f;
                for (int p = 0; p < 16; ++p) { const float r = rg[p * 256 + tid], ig = rg[(16 + p) * 256 + tid], la = nl * r, a = expf(la), mult = sqrtf(-expm1f(2.f * la));
                    hh = a * hh + mult * ig * xs[p * 256 + tid]; }
                HMETA[ch] = hh; }
            __syncthreads();
        }
        if (BOTH(3)) GRID_BAR();
    }

    if (IN(4)) {
        const int gid = bx * (NWAVES * 64) + tid;
        if (gid < BATCH * D) { const int b = gid >> 11, c = gid & (D - 1); float carry = HMETA[c];
#pragma unroll 8
            for (int k = 0; k < 64; ++k) { const size_t o = (size_t)(b * 64 + k) * D + c; CARRY[o] = carry; carry = ACH[o] * carry + BCH[o]; } }
        if (BOTH(4)) GRID_BAR();
    }

    if (IN(5)) {
        const int gw = vcu * NWAVES + wave, NGW = G * NWAVES;
        for (int m = gw; m < MR; m += NGW) { const bf16* rowp = PROJ + (size_t)m * PST; const float* cr = CARRY + (size_t)(m >> 6) * D;
#pragma unroll
            for (int q = 0; q < 4; ++q) { const int c = 512 * q + 8 * lane; float p1[8], gh[8], ga[8], o[8];
                unpack8(*(const v4u*)(rowp + COL_SGP + c), p1); unpack8(*(const v4u*)(rowp + COL_VLRU + c), gh); unpack8(*(const v4u*)(rowp + COL_G + c), ga);
                const f32x4 c0 = *(const f32x4*)(cr + c), c1 = *(const f32x4*)(cr + c + 4);
#pragma unroll
                for (int e = 0; e < 8; ++e) o[e] = p1[e] + gh[e] + ga[e] * (e < 4 ? c0[e & 3] : c1[e & 3]);
                *(v4u*)(MERGED + (size_t)m * D + c) = pack8(o); } }
        if (BOTH(5)) GRID_BAR();
    }

    if (IN(6)) {
        { pg8::Gemm g{MERGED, WOUT_T, D, D, 1 << 30}; pg8::StaticOrder S; S.init(MR, D, G, bx); EpiH1 E{x, out, H1BF, ROWSS1};
          RUN_GEMM(EpiH1, g, S, E); }
        if (BOTH(6)) GRID_BAR();
    }
    if (IN(7)) {
        { pg8::Gemm g{H1BF, W1_T, D, D, 1 << 30}; pg8::StaticOrder S; S.init(MR, DFF, G, bx); EpiAct E{ACT, ROWSS1};
          RUN_GEMM(EpiAct, g, S, E); }
        if (BOTH(7)) GRID_BAR();
    }
    if (IN(8)) {
        { pg8::Gemm g{ACT, W2_T, DFF, DFF, 1 << 30}; pg8::StaticOrder S; S.init(MR, D, G, bx); EpiOut E{out, ROWSS2};
          RUN_GEMM(EpiOut, g, S, E); }
        if (BOTH(8)) GRID_BAR();
    }
    if (IN(9)) {
        const int gw = vcu * NWAVES + wave, NGW = G * NWAVES;
        for (int m = gw; m < MR; m += NGW) { const float rs = rsqrtf(ROWSS2[m] * (1.f / D) + NORM_EPS); f32x4* orow = (f32x4*)(out + (size_t)m * D) + lane; const f32x4* gr = (const f32x4*)final_g + lane;
#pragma unroll
            for (int j = 0; j < 8; ++j) { f32x4 v = orow[64 * j]; const f32x4 gg = gr[64 * j]; v = v * rs * gg; orow[64 * j] = v; } }
    }
#undef IN
#undef BOTH
#undef tid
#undef lane
#undef wave
}

extern "C" void kernel_launch(void* const* d_in, const int* in_sizes, int n_in, void* d_out, int out_size, void* d_ws, size_t ws_size, hipStream_t stream) {
    static int grid = 0;
    if (grid == 0) {
        if (n_in != 18 || in_sizes[0] != MR * D || out_size != MR * D || ws_size < WS_END) { fprintf(stderr, "kernel_launch: unexpected shapes or workspace (n_in %d, ws %zu)\n", n_in, ws_size); grid = -1; return; }
        int dev = 0, cus = 0;
        if (hipGetDevice(&dev) != hipSuccess || hipDeviceGetAttribute(&cus, hipDeviceAttributeMultiprocessorCount, dev) != hipSuccess) { grid = -1; return; }
        if (hipFuncSetAttribute((const void*)fwd_kernel, hipFuncAttributeMaxDynamicSharedMemorySize, LDS_BYTES) != hipSuccess) { grid = -1; return; }
        (void)hipGetLastError();
        grid = cus;
    }
    if (grid < 0) return;
    (void)hipMemsetAsync((char*)d_ws + WS_CTL, 0, CTL_ZERO_BYTES, stream);
    Args a{};
    for (int i = 0; i < 18; ++i) a.in[i] = (const float*)d_in[i];
    a.out = (float*)d_out; a.ws = (unsigned char*)d_ws;
    if (N_LAUNCHES == 1) { a.ph_lo = 0; a.ph_hi = NPHASES; a.li = 0; hipLaunchKernelGGL(fwd_kernel, dim3(grid), dim3(NWAVES * 64), LDS_BYTES, stream, a); }
    else for (int li = 0; li < NPHASES; ++li) { a.ph_lo = li; a.ph_hi = li + 1; a.li = li; hipLaunchKernelGGL(fwd_kernel, dim3(grid), dim3(NWAVES * 64), LDS_BYTES, stream, a); }
}
```

```cpp
#include <hip/hip_runtime.h>
#include <cstdio>
#include <cstdint>

#ifndef MK_N_LAUNCHES
#define MK_N_LAUNCHES 1
#endif
#ifndef MK_SIMPLE_GEMM
#define MK_SIMPLE_GEMM 0
#endif

namespace pg8 {
#define PG8_LAS __attribute__((address_space(3)))
typedef unsigned short bf16_t;
typedef short bf16x8 __attribute__((ext_vector_type(8)));
typedef float f32x4 __attribute__((ext_vector_type(4)));
typedef unsigned u32x4 __attribute__((ext_vector_type(4)));
typedef unsigned u32x2 __attribute__((ext_vector_type(2)));
constexpr int BM = 256, BK = 64, HALF = 128, HTB = HALF * BK * 2  , STAGE_BYTES = 8 * HTB, NXCD = 8, WGM = 8;

__host__ __device__ __forceinline__ int lds_byte(int r, int c) { const int st = (r >> 4) * 2 + (c >> 5), rr = r & 15, cc = c & 31, ob = rr * 64 + cc * 2; return st * 1024 + (ob ^ (((ob >> 9) & 1) << 5)); }
__host__ __device__ __forceinline__ void stage_rc(int b, int& R, int& C) { const int st = b / 1024, sb = b % 1024, swz = sb ^ (((sb >> 9) & 1) << 5); R = (st >> 1) * 16 + swz / 64; C = (st & 1) * 32 + (swz % 64) / 2; }
__host__ __device__ __forceinline__ int perm32(int rho) { const int n = rho >> 4, i = rho & 15; return 8 * (i >> 2) + 4 * n + (i & 3); }

__device__ __forceinline__ int tid_opaque() { int t = (int)threadIdx.x; asm volatile("" : "+v"(t)); return t; }
struct Unit { int pm, pn; };
struct Gemm { const bf16_t* A; const bf16_t* Bt; int lda, K, tpg; };

struct StaticOrder {
    int nM, nN, nwg, G, c;
    __host__ __device__ void init(int M, int N, int G_, int c_) { nM = M / BM; nN = N / BM; nwg = nM * nN; G = G_; c = c_; }
    __host__ __device__ bool next(int i, Unit& u) const {
        const long L = (long)i * G + c; if (L >= nwg) return false;
        int wgid = (int)L; { const int q = nwg / NXCD, r = nwg % NXCD, xcd = wgid % NXCD, off = wgid / NXCD; wgid = (xcd < r ? xcd * (q + 1) : r * (q + 1) + (xcd - r) * q) + off; }
        const int nig = WGM * nN, gid = wgid / nig, fm = gid * WGM, gsz = (nM - fm) < WGM ? (nM - fm) : WGM;
        u.pm = fm + ((wgid % nig) % gsz); u.pn = (wgid % nig) / gsz; return true;
    }
    __device__ __forceinline__ void a_ready(const Unit&) const {}
    __device__ __forceinline__ void done(const Unit&) const {}
};

__device__ __forceinline__ unsigned cvt_pk_bf16(float lo, float hi) { unsigned r; asm volatile("v_cvt_pk_bf16_f32 %0, %1, %2" : "=v"(r) : "v"(lo), "v"(hi)); return r; }

template <class Epi, class Sched, bool ALIGN_EPI = false, bool SP2 = false>
__device__ __forceinline__ void gemm_phase(PG8_LAS unsigned char* lds, const Gemm g, const Sched& S, const Epi& E) {
    const int tid = tid_opaque(), wid = __builtin_amdgcn_readfirstlane(tid >> 6), lane = tid & 63, wr = wid >> 2, wc = wid & 3, fr = lane & 15, fq = lane >> 4;
    const int K = g.K, nt = K / BK, lda = g.lda;
    unsigned voffA[2], voffB[2];
#pragma unroll
    for (int i = 0; i < 2; ++i) { int R, C; stage_rc(tid * 16 + i * 8192, R, C); const int Rb = Epi::PERM ? ((R & ~31) + perm32(R & 31)) : R;
        voffA[i] = (unsigned)(R * lda + C) * 2u; voffB[i] = (unsigned)(Rb * K + C) * 2u; }
    const size_t kstep = (size_t)(BK * 2);
    const size_t hstepA = (size_t)HALF * lda * 2, hstepB = (size_t)HALF * K * 2;
    const size_t tstepA = 2 * hstepA, tstepB = 2 * hstepB;
    const unsigned ldsw = (unsigned)wid * 1024u;
    const int aoff = lds_byte(wr * 64 + fr, fq * 8), boff = lds_byte(wc * 32 + fr, fq * 8);
#define PG8_SA(b, h) (((b) * 2 + (h)) * HTB)
#define PG8_SB(b, h) ((4 + (b) * 2 + (h)) * HTB)
#define PG8_STAGE(bufoff, gbase, voff) do { _Pragma("unroll") for (int _i = 0; _i < 2; ++_i) \
        __builtin_amdgcn_global_load_lds((const unsigned*)((const char*)(gbase) + (voff)[_i]), (PG8_LAS unsigned*)(lds + (bufoff) + ldsw + _i * 8192), 16, 0, 0); } while (0)
#define PG8_LDA(dst, b, h) do { _Pragma("unroll") for (int m = 0; m < 4; ++m) _Pragma("unroll") for (int k = 0; k < 2; ++k) dst[m][k] = *(const PG8_LAS bf16x8*)(lds + PG8_SA(b, h) + aoff + m * 2048 + k * 1024); } while (0)
#define PG8_LDB(dst, b, h) do { _Pragma("unroll") for (int n = 0; n < 2; ++n) _Pragma("unroll") for (int k = 0; k < 2; ++k) dst[n][k] = *(const PG8_LAS bf16x8*)(lds + PG8_SB(b, h) + boff + n * 2048 + k * 1024); } while (0)
#define PG8_MMA(ai, bj, At, Bt) do { __builtin_amdgcn_s_setprio(1); _Pragma("unroll") for (int m = 0; m < 4; ++m) _Pragma("unroll") for (int n = 0; n < 2; ++n) _Pragma("unroll") for (int k = 0; k < 2; ++k) \
        acc[ai][bj][m][n] = __builtin_amdgcn_mfma_f32_16x16x32_bf16(Bt[n][k], At[m][k], acc[ai][bj][m][n], 0, 0, 0); __builtin_amdgcn_s_setprio(0); } while (0)
#define PG8_WAIT_V(n) asm volatile("s_waitcnt vmcnt(" #n ")" ::: "memory")
#define PG8_WAIT_L(n) asm volatile("s_waitcnt lgkmcnt(" #n ")" ::: "memory")
#define PG8_BAR __builtin_amdgcn_s_barrier()
#define PG8_SCHED __builtin_amdgcn_sched_barrier(0)
    Unit cur, nxt; int ui = 0;
    if (!S.next(0, cur)) return;
    f32x4 acc[2][2][4][2];
#pragma unroll
    for (int a = 0; a < 2; ++a)
#pragma unroll
        for (int b = 0; b < 2; ++b)
#pragma unroll
            for (int m = 0; m < 4; ++m)
#pragma unroll
                for (int n = 0; n < 2; ++n) acc[a][b][m][n] = (f32x4){0.f, 0.f, 0.f, 0.f};
    bf16x8 At[4][2], B0[2][2], B1[2][2];
    const char* cA = (const char*)g.A + (size_t)cur.pm * tstepA + (size_t)(cur.pn / g.tpg) * K * 2; const char* cB = (const char*)g.Bt + (size_t)cur.pn * tstepB;
    S.a_ready(cur);
    if constexpr (SP2) {
        PG8_STAGE(PG8_SB(0, 0), cB, voffB); PG8_STAGE(PG8_SB(0, 1), cB + hstepB, voffB); PG8_STAGE(PG8_SA(0, 0), cA, voffA); PG8_STAGE(PG8_SA(0, 1), cA + hstepA, voffA);
        if (wr == 1) PG8_BAR;
        PG8_WAIT_V(2); PG8_BAR;
        PG8_STAGE(PG8_SB(1, 0), cB + kstep, voffB); PG8_STAGE(PG8_SA(1, 0), cA + kstep, voffA); PG8_STAGE(PG8_SB(1, 1), cB + hstepB + kstep, voffB);
        PG8_WAIT_V(6); PG8_BAR;
    } else {
        PG8_STAGE(PG8_SB(0, 0), cB, voffB); PG8_STAGE(PG8_SA(0, 0), cA, voffA); PG8_STAGE(PG8_SB(0, 1), cB + hstepB, voffB); PG8_STAGE(PG8_SA(0, 1), cA + hstepA, voffA);
        if (wr == 1) PG8_BAR;
        PG8_WAIT_V(4); PG8_BAR;
        PG8_STAGE(PG8_SB(1, 0), cB + kstep, voffB); PG8_STAGE(PG8_SA(1, 0), cA + kstep, voffA); PG8_STAGE(PG8_SB(1, 1), cB + hstepB + kstep, voffB);
        PG8_WAIT_V(6); PG8_BAR;
    }
    for (;;) {
        const bool has_next = S.next(ui + 1, nxt);
        const char* nA = has_next ? (const char*)g.A + (size_t)nxt.pm * tstepA + (size_t)(nxt.pn / g.tpg) * K * 2 : cA; const char* nB = has_next ? (const char*)g.Bt + (size_t)nxt.pn * tstepB : cB;
        for (int t = 0; t < nt; t += 2) {
            const bool last = (t == nt - 2);
            const char* a1 = cA + (size_t)(t + 1) * kstep;
            const char* a2 = last ? nA : cA + (size_t)(t + 2) * kstep; const char* b2 = last ? nB : cB + (size_t)(t + 2) * kstep;
            const char* a3 = a2 + kstep; const char* b3 = b2 + kstep;
            if (last && has_next) S.a_ready(nxt);
            if constexpr (SP2) {
            PG8_LDB(B0, 0, 0); PG8_LDB(B1, 0, 1); PG8_SCHED; PG8_LDA(At, 0, 0); PG8_STAGE(PG8_SA(1, 1), a1 + hstepA, voffA);
            PG8_WAIT_V(8); PG8_WAIT_L(0); PG8_BAR; PG8_MMA(0, 0, At, B0); PG8_MMA(0, 1, At, B1); PG8_BAR; PG8_SCHED;
            PG8_LDA(At, 0, 1); PG8_STAGE(PG8_SB(0, 0), b2, voffB); PG8_STAGE(PG8_SB(0, 1), b2 + hstepB, voffB); PG8_STAGE(PG8_SA(0, 0), a2, voffA);
            PG8_WAIT_V(8); PG8_WAIT_L(0); PG8_BAR; PG8_MMA(1, 0, At, B0); PG8_MMA(1, 1, At, B1); PG8_BAR; PG8_SCHED;
            PG8_LDB(B0, 1, 0); PG8_LDB(B1, 1, 1); PG8_SCHED; PG8_LDA(At, 1, 0); PG8_STAGE(PG8_SA(0, 1), a2 + hstepA, voffA);
            PG8_WAIT_V(8); PG8_WAIT_L(0); PG8_BAR; PG8_MMA(0, 0, At, B0); PG8_MMA(0, 1, At, B1); PG8_BAR; PG8_SCHED;
            PG8_LDA(At, 1, 1); PG8_STAGE(PG8_SB(1, 0), b3, voffB); PG8_STAGE(PG8_SB(1, 1), b3 + hstepB, voffB); PG8_STAGE(PG8_SA(1, 0), a3, voffA);
            PG8_WAIT_V(8); PG8_WAIT_L(0); PG8_BAR; PG8_MMA(1, 0, At, B0); PG8_MMA(1, 1, At, B1); PG8_BAR; PG8_SCHED;
            } else {
            PG8_LDB(B0, 0, 0); PG8_SCHED; PG8_LDA(At, 0, 0); PG8_STAGE(PG8_SA(1, 1), a1 + hstepA, voffA);
            PG8_WAIT_L(8); PG8_BAR; PG8_WAIT_L(0); PG8_MMA(0, 0, At, B0); PG8_BAR; PG8_SCHED;
            PG8_LDB(B1, 0, 1); PG8_STAGE(PG8_SB(0, 0), b2, voffB);
            PG8_BAR; PG8_WAIT_L(0); PG8_MMA(0, 1, At, B1); PG8_BAR;
            PG8_LDA(At, 0, 1); PG8_STAGE(PG8_SA(0, 0), a2, voffA);
            PG8_BAR; PG8_WAIT_L(0); PG8_MMA(1, 0, At, B0); PG8_BAR; PG8_SCHED;
            PG8_STAGE(PG8_SB(0, 1), b2 + hstepB, voffB);
            PG8_WAIT_V(6); PG8_BAR; PG8_MMA(1, 1, At, B1); PG8_BAR;
            PG8_LDB(B0, 1, 0); PG8_SCHED; PG8_LDA(At, 1, 0); PG8_STAGE(PG8_SA(0, 1), a2 + hstepA, voffA);
            PG8_WAIT_L(8); PG8_BAR; PG8_WAIT_L(0); PG8_MMA(0, 0, At, B0); PG8_BAR; PG8_SCHED;
            PG8_LDB(B1, 1, 1); PG8_STAGE(PG8_SB(1, 0), b3, voffB);
            PG8_BAR; PG8_WAIT_L(0); PG8_MMA(0, 1, At, B1); PG8_BAR;
            PG8_LDA(At, 1, 1); PG8_STAGE(PG8_SA(1, 0), a3, voffA);
            PG8_BAR; PG8_WAIT_L(0); PG8_MMA(1, 0, At, B0); PG8_BAR; PG8_SCHED;
            PG8_STAGE(PG8_SB(1, 1), b3 + hstepB, voffB);
            PG8_WAIT_V(6); PG8_BAR; PG8_MMA(1, 1, At, B1); PG8_BAR;
            }
        }
        if constexpr (ALIGN_EPI) { if (wr == 0) PG8_BAR; }
        E(acc, cur, wr, wc, fr, fq); S.done(cur);
        if (!has_next) break;
#pragma unroll
        for (int a = 0; a < 2; ++a)
#pragma unroll
            for (int b = 0; b < 2; ++b)
#pragma unroll
                for (int m = 0; m < 4; ++m)
#pragma unroll
                    for (int n = 0; n < 2; ++n) acc[a][b][m][n] = (f32x4){0.f, 0.f, 0.f, 0.f};
        cur = nxt; cA = nA; cB = nB; ++ui;
        if constexpr (ALIGN_EPI) { if (wr == 1) PG8_BAR; }
    }
    PG8_WAIT_V(0);
    if constexpr (!ALIGN_EPI) { if (wr == 0) PG8_BAR; }
    PG8_BAR;
#undef PG8_SA
#undef PG8_SB
#undef PG8_STAGE
#undef PG8_LDA
#undef PG8_LDB
#undef PG8_MMA
#undef PG8_WAIT_V
#undef PG8_WAIT_L
#undef PG8_BAR
#undef PG8_SCHED
}

template <class Epi, class Sched>
__device__ __forceinline__ void gemm_simple(const Gemm g, const Sched& S, const Epi& E) {
    const int tid = tid_opaque(), wid = __builtin_amdgcn_readfirstlane(tid >> 6), lane = tid & 63, wr = wid >> 2, wc = wid & 3, fr = lane & 15, fq = lane >> 4;
    Unit cur;
    for (int ui = 0; S.next(ui, cur); ++ui) {
        f32x4 acc[2][2][4][2];
#pragma unroll
        for (int a = 0; a < 2; ++a)
#pragma unroll
            for (int b = 0; b < 2; ++b)
#pragma unroll
                for (int m = 0; m < 4; ++m)
#pragma unroll
                    for (int n = 0; n < 2; ++n) acc[a][b][m][n] = (f32x4){0.f, 0.f, 0.f, 0.f};
        const bf16_t* Ab = g.A + (size_t)cur.pm * 256 * g.lda + (size_t)(cur.pn / g.tpg) * g.K;
        const bf16_t* Bb = g.Bt + (size_t)cur.pn * 256 * g.K;
        for (int k0 = 0; k0 < g.K; k0 += 32) {
            bf16x8 a[2][4], b[2][2];
#pragma unroll
            for (int ai = 0; ai < 2; ++ai)
#pragma unroll
                for (int m = 0; m < 4; ++m) a[ai][m] = *(const bf16x8*)(Ab + (size_t)(128 * ai + 64 * wr + 16 * m + fr) * g.lda + k0 + 8 * fq);
#pragma unroll
            for (int bj = 0; bj < 2; ++bj)
#pragma unroll
                for (int n = 0; n < 2; ++n) { const int slot = 16 * n + fr; const int rr = Epi::PERM ? perm32(slot) : slot;
                    b[bj][n] = *(const bf16x8*)(Bb + (size_t)(128 * bj + 32 * wc + rr) * g.K + k0 + 8 * fq); }
#pragma unroll
            for (int ai = 0; ai < 2; ++ai)
#pragma unroll
                for (int bj = 0; bj < 2; ++bj)
#pragma unroll
                    for (int m = 0; m < 4; ++m)
#pragma unroll
                        for (int n = 0; n < 2; ++n) acc[ai][bj][m][n] = __builtin_amdgcn_mfma_f32_16x16x32_bf16(b[bj][n], a[ai][m], acc[ai][bj][m][n], 0, 0, 0);
        }
        E(acc, cur, wr, wc, fr, fq);
    }
    __syncthreads();
}
}

constexpr int NWAVES = 8;
constexpr int N_LAUNCHES = MK_N_LAUNCHES;
constexpr int NPHASES = 9;
constexpr int D = 2048, SEQ = 4096, BATCH = 2, NMETA = 16, MR = BATCH * SEQ, INC = 5 * D, DFF = 4 * D;
constexpr int NCHUNK = MR / 64;
constexpr float NORM_EPS = 1e-6f;
constexpr int PST = 4 * D;
constexpr int COL_VPOOL = 0, COL_VLRU = D, COL_G = 2 * D, COL_SGP = 3 * D;

constexpr size_t MiB = 1u << 20;
constexpr size_t WS_CTL = 0, CTL_ZERO_BYTES = 1 * MiB;
constexpr size_t WS_ROWSS1 = 256 * 1024, WS_ROWSS2 = 320 * 1024;
constexpr size_t WS_WIN_T = 1 * MiB;
constexpr size_t WS_XCB = WS_WIN_T, WS_H1BF = WS_WIN_T;
constexpr size_t WS_WOUT_T = 41 * MiB;
constexpr size_t WS_W1_T = 49 * MiB;
constexpr size_t WS_W2_T = 81 * MiB;
constexpr size_t WS_POOL_T = 113 * MiB;
constexpr size_t WS_GATE_T = 115 * MiB;
constexpr size_t WS_PROJ = 117 * MiB;
constexpr size_t WS_ACT = WS_PROJ;
constexpr size_t WS_U = 277 * MiB;
constexpr size_t WS_SMALL = 309 * MiB;
constexpr size_t WS_UMETA = WS_SMALL;
constexpr size_t WS_PROJMETA = WS_SMALL + 64 * 1024;
constexpr size_t WS_XCMETA = WS_SMALL + 320 * 1024;
constexpr size_t WS_HMETA = WS_SMALL + 448 * 1024;
constexpr size_t WS_NLS = WS_SMALL + 456 * 1024;
constexpr size_t WS_ACH = WS_SMALL + 1 * MiB;
constexpr size_t WS_BCH = WS_SMALL + 2 * MiB;
constexpr size_t WS_CARRY = WS_SMALL + 3 * MiB;
constexpr size_t WS_END = 313 * MiB;
constexpr int CW_TMO = 0, CW_BAR = 4096;

constexpr int RING_OFF = 0, RING_BYTES = 131072;
constexpr int LDSCTL_OFF = RING_BYTES, MISC_OFF = LDSCTL_OFF + 320;
constexpr int LDS_BYTES = 147456;

#define GAS __attribute__((address_space(1)))
#define LAS __attribute__((address_space(3)))
typedef unsigned short bf16;
typedef unsigned v4u __attribute__((ext_vector_type(4)));
typedef unsigned v2u __attribute__((ext_vector_type(2)));
typedef float f32x4 __attribute__((ext_vector_type(4)));
typedef short bf16x8 __attribute__((ext_vector_type(8)));
typedef GAS unsigned gu32;
#define RLX_AGENT __ATOMIC_RELAXED, __HIP_MEMORY_SCOPE_AGENT
#define LDS_WAIT() asm volatile("s_waitcnt lgkmcnt(0)" ::: "memory")
#define VM_WAIT() asm volatile("s_waitcnt vmcnt(0)" ::: "memory")
__device__ __forceinline__ unsigned f2bf(float f) { unsigned u = __builtin_bit_cast(unsigned, f); return (u + 0x7fffu + ((u >> 16) & 1u)) >> 16; }
__device__ __forceinline__ unsigned pk2(float lo, float hi) { return f2bf(lo) | (f2bf(hi) << 16); }
__device__ __forceinline__ float bflo(unsigned w) { return __builtin_bit_cast(float, w << 16); }
__device__ __forceinline__ float bfhi(unsigned w) { return __builtin_bit_cast(float, w & 0xffff0000u); }
__device__ __forceinline__ void unpack8(v4u w, float (&f)[8]) { f[0] = bflo(w.x); f[1] = bfhi(w.x); f[2] = bflo(w.y); f[3] = bfhi(w.y); f[4] = bflo(w.z); f[5] = bfhi(w.z); f[6] = bflo(w.w); f[7] = bfhi(w.w); }
__device__ __forceinline__ v4u pack8(const float (&f)[8]) { v4u w; w.x = pg8::cvt_pk_bf16(f[0], f[1]); w.y = pg8::cvt_pk_bf16(f[2], f[3]); w.z = pg8::cvt_pk_bf16(f[4], f[5]); w.w = pg8::cvt_pk_bf16(f[6], f[7]); return w; }
__device__ __forceinline__ float sigm(float z) { return __builtin_amdgcn_rcpf(1.f + __builtin_amdgcn_exp2f(-1.4426950408889634f * z)); }
__device__ __forceinline__ float expm1_neg(float x) {
    float p = 1.f / 5040.f; p = p * x + 1.f / 720.f; p = p * x + 1.f / 120.f; p = p * x + 1.f / 24.f; p = p * x + 1.f / 6.f; p = p * x + 0.5f; p = p * x + 1.f; p = p * x;
    const float q = __builtin_amdgcn_exp2f(1.4426950408889634f * x) - 1.f;
    return x > -0.25f ? p : q;
}
__device__ __forceinline__ float gelu_tanh(float x) { return x * sigm(1.5957691216057308f * (x + 0.044715f * x * x * x)); }
template <int S> __device__ __forceinline__ float dpp_shr(float oldv, float src) {
    return __builtin_bit_cast(float, __builtin_amdgcn_update_dpp(__builtin_bit_cast(int, oldv), __builtin_bit_cast(int, src), 0x110 + S, 0xf, 0xf, false));
}

typedef f32x4 AccT[2][2][4][2];
struct EpiProj {
    static constexpr bool PERM = true;
    bf16* O;
    __device__ __forceinline__ void operator()(AccT& acc, const pg8::Unit& u, int wr, int wc, int fr, int fq) const {
        const int row0 = u.pm * 256 + wr * 64 + fr;
        if (u.pn >= 16 && u.pn < 32) {
            const int col0 = COL_G + (u.pn - 16) * 128 + wc * 32 + 8 * fq;
#pragma unroll
            for (int ai = 0; ai < 2; ++ai)
#pragma unroll
                for (int m = 0; m < 4; ++m) { float o[8];
#pragma unroll
                    for (int e = 0; e < 8; ++e) o[e] = sigm(acc[ai][1][m][e >> 2][e & 3]) * gelu_tanh(acc[ai][0][m][e >> 2][e & 3]);
                    *(v4u*)(O + (size_t)(row0 + ai * 128 + m * 16) * PST + col0) = pack8(o); }
        } else {
            const bool sg = u.pn >= 32; const int col0 = (sg ? COL_SGP + (u.pn - 32) * 256 : u.pn * 256) + wc * 32 + 8 * fq;
#pragma unroll
            for (int ai = 0; ai < 2; ++ai)
#pragma unroll
                for (int m = 0; m < 4; ++m) { bf16* rowp = O + (size_t)(row0 + ai * 128 + m * 16) * PST + col0;
#pragma unroll
                    for (int bj = 0; bj < 2; ++bj) { float o[8];
#pragma unroll
                        for (int e = 0; e < 8; ++e) { const float v = acc[ai][bj][m][e >> 2][e & 3]; o[e] = sg ? sigm(v) : v; }
                        *(v4u*)(rowp + bj * 128) = pack8(o); } }
        }
    }
};
struct EpiH1 {
    static constexpr bool PERM = false;
    const float* x; float* out; bf16* h1bf; float* rowss;
    __device__ __forceinline__ void operator()(AccT& acc, const pg8::Unit& u, int wr, int wc, int fr, int fq) const {
        const int row0 = u.pm * 256 + wr * 64 + fr, col0 = u.pn * 256 + wc * 32 + 4 * fq;
#pragma unroll
        for (int ai = 0; ai < 2; ++ai)
#pragma unroll
            for (int m = 0; m < 4; ++m) { const int row = row0 + ai * 128 + m * 16; const size_t off = (size_t)row * D + col0; float ss = 0.f;
#pragma unroll
                for (int bj = 0; bj < 2; ++bj)
#pragma unroll
                    for (int n = 0; n < 2; ++n) { const f32x4 h = *(const f32x4*)(x + off + bj * 128 + n * 16) + acc[ai][bj][m][n];
                        *(f32x4*)(out + off + bj * 128 + n * 16) = h; ss += (h[0] * h[0] + h[1] * h[1]) + (h[2] * h[2] + h[3] * h[3]);
                        v2u w; w.x = pg8::cvt_pk_bf16(h[0], h[1]); w.y = pg8::cvt_pk_bf16(h[2], h[3]); *(v2u*)(h1bf + off + bj * 128 + n * 16) = w; }
                ss += __shfl_xor(ss, 16); ss += __shfl_xor(ss, 32);
                if (fq == 0) atomicAdd(rowss + row, ss); }
    }
};
struct EpiAct {
    static constexpr bool PERM = true;
    bf16* O; const float* rowss;
    __device__ __forceinline__ void operator()(AccT& acc, const pg8::Unit& u, int wr, int wc, int fr, int fq) const {
        const int row0 = u.pm * 256 + wr * 64 + fr, col0 = u.pn * 256 + wc * 32 + 8 * fq;
#pragma unroll
        for (int ai = 0; ai < 2; ++ai)
#pragma unroll
            for (int m = 0; m < 4; ++m) { const int row = row0 + ai * 128 + m * 16; const float rs = rsqrtf(rowss[row] * (1.f / D) + NORM_EPS); bf16* rowp = O + (size_t)row * DFF + col0;
#pragma unroll
                for (int bj = 0; bj < 2; ++bj) { float o[8];
#pragma unroll
                    for (int e = 0; e < 8; ++e) { const float v = fmaxf(rs * acc[ai][bj][m][e >> 2][e & 3], 0.f); o[e] = v * v; }
                    *(v4u*)(rowp + bj * 128) = pack8(o); } }
    }
};
struct EpiOut {
    static constexpr bool PERM = false;
    float* out; float* rowss;
    __device__ __forceinline__ void operator()(AccT& acc, const pg8::Unit& u, int wr, int wc, int fr, int fq) const {
        const int row0 = u.pm * 256 + wr * 64 + fr, col0 = u.pn * 256 + wc * 32 + 4 * fq;
#pragma unroll
        for (int ai = 0; ai < 2; ++ai)
#pragma unroll
            for (int m = 0; m < 4; ++m) { const int row = row0 + ai * 128 + m * 16; const size_t off = (size_t)row * D + col0; float ss = 0.f;
#pragma unroll
                for (int bj = 0; bj < 2; ++bj)
#pragma unroll
                    for (int n = 0; n < 2; ++n) { const f32x4 h = *(const f32x4*)(out + off + bj * 128 + n * 16) + acc[ai][bj][m][n];
                        *(f32x4*)(out + off + bj * 128 + n * 16) = h; ss += (h[0] * h[0] + h[1] * h[1]) + (h[2] * h[2] + h[3] * h[3]); }
                ss += __shfl_xor(ss, 16); ss += __shfl_xor(ss, 32);
                if (fq == 0) atomicAdd(rowss + row, ss); }
    }
};

#define XB_TMO      128
#define XB_XCNT(j)  (256  + 64 * (j))
#define XB_XSUB(j)  (1280 + 64 * (j))
#define XB_XGEN(j)  (2304 + 64 * (j))
#define XB_TOP      3328
#define XB_TOPGEN   3392
#define XCD_BAR_WORDS 3456
#define XB_SPIN_CAP (1u << 18)
__device__ __forceinline__ unsigned xb_ld(unsigned* p)              { return __hip_atomic_load(p, __ATOMIC_RELAXED, __HIP_MEMORY_SCOPE_AGENT); }
__device__ __forceinline__ unsigned xb_add(unsigned* p, unsigned v) { return __hip_atomic_fetch_add(p, v, __ATOMIC_RELAXED, __HIP_MEMORY_SCOPE_AGENT); }
__device__ __forceinline__ unsigned xb_xcc_id() { return (unsigned)__builtin_amdgcn_s_getreg((3 << 11) | 20) & 0xFu; }
#define XB_SPIN(cond, bar) do { unsigned _sp = 0; while (cond) { __builtin_amdgcn_s_sleep(1); \
    if ((++_sp & 255u) == 0u) { if (xb_ld(&(bar)[XB_TMO])) break; if (_sp > XB_SPIN_CAP) { atomicAdd(&(bar)[XB_TMO], 1u); break; } } } } while (0)
struct XcdBarrier { unsigned* bar; unsigned x; volatile LAS unsigned* st; };
__device__ __forceinline__ XcdBarrier xcd_barrier_post(unsigned* bar, volatile LAS unsigned* st) {
    XcdBarrier b; b.bar = bar; b.x = xb_xcc_id(); b.st = st;
    if (threadIdx.x == 0) (void)xb_add(&bar[XB_XCNT(b.x)], 1u);
    return b;
}
__device__ __forceinline__ void xcd_barrier_complete(unsigned* bar, unsigned x, unsigned& nloc, unsigned& nx) {
    const unsigned G = gridDim.x * gridDim.y * gridDim.z;
    unsigned sum, cnt, mine, sp = 0u;
    for (;;) {
        sum = 0u; cnt = 0u; mine = 0u;
#pragma unroll
        for (unsigned j = 0; j < 16; ++j) { const unsigned c = xb_ld(&bar[XB_XCNT(j)]); sum += c; cnt += (c > 0u) ? 1u : 0u; mine = (j == x) ? c : mine; }
        if (sum == G) break;
        __builtin_amdgcn_s_sleep(1);
        if ((++sp & 255u) == 0u) { if (xb_ld(&bar[XB_TMO])) break; if (sp > XB_SPIN_CAP) { atomicAdd(&bar[XB_TMO], 1u); break; } }
    }
    nloc = mine > 0u ? mine : 1u; nx = cnt > 0u ? cnt : 1u;
}
__device__ __forceinline__ void xcd_barrier(const XcdBarrier& b) {
    asm volatile("s_waitcnt vmcnt(0)" ::: "memory");
    __syncthreads();
    if (threadIdx.x == 0) {
        unsigned* bar = b.bar;
        __builtin_amdgcn_s_waitcnt(0);
        unsigned nloc = b.st[0], nx = b.st[1];
        if (nloc == 0u) { xcd_barrier_complete(bar, b.x, nloc, nx); b.st[0] = nloc; b.st[1] = nx; }
        const unsigned old = xb_add(&bar[XB_XSUB(b.x)], 1u);
        const unsigned gen = old / nloc;
        if (old + 1u == (gen + 1u) * nloc) {
            __builtin_amdgcn_fence(__ATOMIC_RELEASE, "agent");
            asm volatile("s_waitcnt vmcnt(0)" ::: "memory");
            const unsigned og = xb_add(&bar[XB_TOP], 1u);
            const unsigned tg = og / nx;
            if (og + 1u == (tg + 1u) * nx) xb_add(&bar[XB_TOPGEN], 1u);
            else XB_SPIN(xb_ld(&bar[XB_TOPGEN]) == tg, bar);
            __builtin_amdgcn_fence(__ATOMIC_ACQUIRE, "agent");
            xb_add(&bar[XB_XGEN(b.x)], 1u);
            asm volatile("s_waitcnt vmcnt(0)" ::: "memory");
        } else {
            XB_SPIN(xb_ld(&bar[XB_XGEN(b.x)]) == gen, bar);
            __builtin_amdgcn_fence(__ATOMIC_ACQUIRE, "agent");
            asm volatile("s_waitcnt vmcnt(0)" ::: "memory");
        }
    }
    __syncthreads();
}

__device__ __forceinline__ float wave_sum(float v) {
#pragma unroll
    for (int o = 1; o < 64; o <<= 1) v += __shfl_xor(v, o);
    return v;
}
__device__ __forceinline__ void p0_tr_item(const float* W, int ldw, int k0, int n0, bf16* WT, int ldt, int dst_row0, const float* scale, LAS float* scr, int lane) {
#pragma unroll 8
    for (int i = 0; i < 32; ++i) { const int kk = 2 * i + (lane >> 5); float v = W[(size_t)(k0 + kk) * ldw + n0 + (lane & 31)]; if (scale) v *= scale[k0 + kk]; scr[kk * 33 + (lane & 31)] = v; }
    LDS_WAIT(); asm volatile("" ::: "memory");
    const int c = lane & 7;
#pragma unroll
    for (int j = 0; j < 4; ++j) { const int n = (lane >> 3) + 8 * j; const LAS float* s = scr + (8 * c) * 33 + n;
        v4u o; o.x = pk2(s[0 * 33], s[1 * 33]); o.y = pk2(s[2 * 33], s[3 * 33]); o.z = pk2(s[4 * 33], s[5 * 33]); o.w = pk2(s[6 * 33], s[7 * 33]);
        *(v4u*)(WT + (size_t)(dst_row0 + n) * ldt + k0 + 8 * c) = o; }
    LDS_WAIT(); asm volatile("" ::: "memory");
}
__device__ __forceinline__ void rms_row_to_bf16(const float* xrow, const float* g, bf16* orow, int lane) {
    const f32x4* xr = (const f32x4*)xrow + lane; const f32x4* gr = (const f32x4*)g + lane;
    f32x4 v[8]; float s = 0.f;
#pragma unroll
    for (int j = 0; j < 8; ++j) { v[j] = xr[64 * j]; s += (v[j][0] * v[j][0] + v[j][1] * v[j][1]) + (v[j][2] * v[j][2] + v[j][3] * v[j][3]); }
    const float rs = rsqrtf(wave_sum(s) * (1.f / D) + NORM_EPS);
    v2u* o8 = (v2u*)orow + lane;
#pragma unroll
    for (int j = 0; j < 8; ++j) { const f32x4 gg = gr[64 * j]; v2u w; w.x = pk2(v[j][0] * rs * gg[0], v[j][1] * rs * gg[1]); w.y = pk2(v[j][2] * rs * gg[2], v[j][3] * rs * gg[3]); o8[64 * j] = w; }
}
__device__ __forceinline__ void load_row8(const bf16* proj, const float* pmeta, int b, int tpos, int cg, int c0, float (&f)[8]) {
    if (tpos >= 0) unpack8(*(const v4u*)(proj + (size_t)(b * SEQ + tpos) * PST + cg * D + c0), f);
    else { const float* p = pmeta + (size_t)(NMETA + tpos) * (2 * D) + cg * D + c0; const f32x4 a = *(const f32x4*)p, c = *(const f32x4*)(p + 4);
#pragma unroll
        for (int e = 0; e < 4; ++e) { f[e] = a[e]; f[4 + e] = c[e]; } }
}


constexpr int MX_AD = 0, MX_AX = 65536;
__device__ __forceinline__ v4u load_row8p(const bf16* proj, const float* pmeta, int b, int tpos, int cg, int c0) {
    if (tpos >= 0) return *(const v4u*)(proj + (size_t)(b * SEQ + tpos) * PST + cg * D + c0);
    const float* p = pmeta + (size_t)(NMETA + tpos) * (2 * D) + cg * D + c0; const f32x4 a = *(const f32x4*)p, c = *(const f32x4*)(p + 4);
    v4u w; w.x = pg8::cvt_pk_bf16(a[0], a[1]); w.y = pg8::cvt_pk_bf16(a[2], a[3]); w.z = pg8::cvt_pk_bf16(c[0], c[1]); w.w = pg8::cvt_pk_bf16(c[2], c[3]); return w;
}
template <int W> __device__ __forceinline__ void build_d(const bf16* proj, const float* pmeta, LAS unsigned char* lds, int b, int tl0, int g, int t) {
    const int kc = t & 63, rb = t >> 6, c0 = 512 * g + 8 * kc;
    v4u v[W + 7];
#pragma unroll
    for (int i = 0; i < W + 7; ++i) v[i] = load_row8p(proj, pmeta, b, tl0 + 8 * rb - (W - 1) + i, 0, c0);
    float s[8], f[8], o[8];
#pragma unroll
    for (int e = 0; e < 8; ++e) s[e] = 0.f;
#pragma unroll
    for (int i = 0; i < W; ++i) { unpack8(v[i], f);
#pragma unroll
        for (int e = 0; e < 8; ++e) s[e] += f[e]; }
#pragma unroll
    for (int r = 0; r < 8; ++r) { unpack8(v[r + W - 1], f);
#pragma unroll
        for (int e = 0; e < 8; ++e) o[e] = s[e] * (1.f / W) - f[e];
        const int row = 8 * rb + r;
        *(LAS v4u*)(lds + MX_AD + row * 1024 + ((kc ^ (row & 15)) << 4)) = pack8(o);
        if (r < 7) { float fo[8]; unpack8(v[r + W], f); unpack8(v[r], fo);
#pragma unroll
            for (int e = 0; e < 8; ++e) s[e] += f[e] - fo[e]; } }
}
__device__ __forceinline__ void build_xc(const bf16* proj, const float* pmeta, const float* conv_w, const float* conv_b, LAS unsigned char* lds, int b, int tl0, int s, int t) {
    const int kc = t & 31, rb = t >> 5, c0 = 256 * s + 8 * kc;
    v4u v[7];
#pragma unroll
    for (int i = 0; i < 7; ++i) v[i] = load_row8p(proj, pmeta, b, tl0 + 4 * rb - 3 + i, 1, c0);
    float o[4][8], f[8];
    { const f32x4 a = *(const f32x4*)(conv_b + c0), c = *(const f32x4*)(conv_b + c0 + 4);
#pragma unroll
      for (int r = 0; r < 4; ++r)
#pragma unroll
          for (int e = 0; e < 4; ++e) { o[r][e] = a[e]; o[r][4 + e] = c[e]; } }
#pragma unroll
    for (int k = 0; k < 4; ++k) { const f32x4 a = *(const f32x4*)(conv_w + k * D + c0), c = *(const f32x4*)(conv_w + k * D + c0 + 4);
#pragma unroll
        for (int r = 0; r < 4; ++r) { unpack8(v[r + k], f);
#pragma unroll
            for (int e = 0; e < 4; ++e) { o[r][e] += a[e] * f[e]; o[r][4 + e] += c[e] * f[4 + e]; } } }
#pragma unroll
    for (int r = 0; r < 4; ++r) { const int row = 4 * rb + r; *(LAS v4u*)(lds + MX_AX + row * 512 + ((kc ^ (row & 15)) << 4)) = pack8(o[r]); }
}
__device__ __forceinline__ void mixer_wave(LAS unsigned char* lds, const bf16* POOL_T, const bf16* GATE_T, const bf16* PROJ, const float* pscale, const float* ba, const float* bx, const float* nls,
                                           bf16* M0, bf16* M1, float* ach, float* bch, int chunk, int chs, int wv, int ln) {
    const int fr = ln & 15, fq = ln >> 4;
    const int brow = chs + 8 * (fr >> 2) + (fr & 3);
    const bf16* pB = POOL_T + (size_t)brow * 512 + 8 * fq;
    const bf16* gA = GATE_T + (size_t)brow * 256 + 8 * fq;
    const bf16* gX = gA + (size_t)D * 256;
    f32x4 accp[4][2], accr[4][2], acci[4][2];
#pragma unroll
    for (int m = 0; m < 4; ++m)
#pragma unroll
        for (int n = 0; n < 2; ++n) { accp[m][n] = (f32x4){0.f, 0.f, 0.f, 0.f}; accr[m][n] = (f32x4){0.f, 0.f, 0.f, 0.f}; acci[m][n] = (f32x4){0.f, 0.f, 0.f, 0.f}; }
    const LAS unsigned char* ad = lds + MX_AD + fr * 1024;
    const LAS unsigned char* ax = lds + MX_AX + fr * 512;
#pragma unroll
    for (int ks = 0; ks < 16; ++ks) {
        const bf16x8 b0 = *(const bf16x8*)(pB + ks * 32), b1 = *(const bf16x8*)(pB + 4 * 512 + ks * 32);
#pragma unroll
        for (int m = 0; m < 4; ++m) { const bf16x8 a = *(const LAS bf16x8*)(ad + m * 16384 + (((4 * ks + fq) ^ fr) << 4));
            accp[m][0] = __builtin_amdgcn_mfma_f32_16x16x32_bf16(b0, a, accp[m][0], 0, 0, 0); accp[m][1] = __builtin_amdgcn_mfma_f32_16x16x32_bf16(b1, a, accp[m][1], 0, 0, 0); }
    }
#pragma unroll
    for (int ks = 0; ks < 8; ++ks) {
        const bf16x8 r0 = *(const bf16x8*)(gA + ks * 32), r1 = *(const bf16x8*)(gA + 4 * 256 + ks * 32), i0 = *(const bf16x8*)(gX + ks * 32), i1 = *(const bf16x8*)(gX + 4 * 256 + ks * 32);
#pragma unroll
        for (int m = 0; m < 4; ++m) { const bf16x8 a = *(const LAS bf16x8*)(ax + m * 8192 + (((4 * ks + fq) ^ fr) << 4));
            accr[m][0] = __builtin_amdgcn_mfma_f32_16x16x32_bf16(r0, a, accr[m][0], 0, 0, 0); accr[m][1] = __builtin_amdgcn_mfma_f32_16x16x32_bf16(r1, a, accr[m][1], 0, 0, 0);
            acci[m][0] = __builtin_amdgcn_mfma_f32_16x16x32_bf16(i0, a, acci[m][0], 0, 0, 0); acci[m][1] = __builtin_amdgcn_mfma_f32_16x16x32_bf16(i1, a, acci[m][1], 0, 0, 0); }
    }
    const int ch0 = chs + 8 * fq;
    float cba[8], cbx[8], cnl[8];
    { const f32x4 a0 = *(const f32x4*)(ba + ch0), a1 = *(const f32x4*)(ba + ch0 + 4), b0 = *(const f32x4*)(bx + ch0), b1 = *(const f32x4*)(bx + ch0 + 4), c0 = *(const f32x4*)(nls + ch0), c1 = *(const f32x4*)(nls + ch0 + 4);
#pragma unroll
      for (int e = 0; e < 4; ++e) { cba[e] = a0[e]; cba[4 + e] = a1[e]; cbx[e] = b0[e]; cbx[4 + e] = b1[e]; cnl[e] = c0[e]; cnl[4 + e] = c1[e]; } }
#pragma unroll
    for (int m = 0; m < 4; ++m) { float xc[8]; unpack8(*(const LAS v4u*)(ax + m * 8192 + (((4 * wv + fq) ^ fr) << 4)), xc);
#pragma unroll
        for (int e = 0; e < 8; ++e) { const float r = sigm(accr[m][e >> 2][e & 3] + cba[e]), ig = sigm(acci[m][e >> 2][e & 3] + cbx[e]);
            const float t = expm1_neg(cnl[e] * r);
            accr[m][e >> 2][e & 3] = 1.f + t; acci[m][e >> 2][e & 3] = __builtin_amdgcn_sqrtf(-t * (2.f + t)) * ig * xc[e]; } }
#pragma unroll
    for (int m = 0; m < 4; ++m)
#pragma unroll
        for (int e = 0; e < 8; ++e) { float A = accr[m][e >> 2][e & 3], B = acci[m][e >> 2][e & 3], As, Bs;
            As = dpp_shr<1>(1.f, A); Bs = dpp_shr<1>(0.f, B); B = A * Bs + B; A = A * As;
            As = dpp_shr<2>(1.f, A); Bs = dpp_shr<2>(0.f, B); B = A * Bs + B; A = A * As;
            As = dpp_shr<4>(1.f, A); Bs = dpp_shr<4>(0.f, B); B = A * Bs + B; A = A * As;
            As = dpp_shr<8>(1.f, A); Bs = dpp_shr<8>(0.f, B); B = A * Bs + B; A = A * As;
            accr[m][e >> 2][e & 3] = A; acci[m][e >> 2][e & 3] = B; }
    const int lane15 = ln | 15;
#pragma unroll
    for (int m = 1; m < 4; ++m)
#pragma unroll
        for (int e = 0; e < 8; ++e) { const float CA = __shfl(accr[m - 1][e >> 2][e & 3], lane15), CB = __shfl(acci[m - 1][e >> 2][e & 3], lane15);
            const float A = accr[m][e >> 2][e & 3], B = acci[m][e >> 2][e & 3];
            acci[m][e >> 2][e & 3] = A * CB + B; accr[m][e >> 2][e & 3] = A * CA; }
    float ps[8];
    { const f32x4 a = *(const f32x4*)(pscale + ch0), c = *(const f32x4*)(pscale + ch0 + 4);
#pragma unroll
      for (int e = 0; e < 4; ++e) { ps[e] = a[e]; ps[4 + e] = c[e]; } }
#pragma unroll
    for (int m = 0; m < 4; ++m) { const size_t row = (size_t)chunk * 64 + 16 * m + fr; const bf16* rowp = PROJ + row * PST + ch0; float gg[8], sg[8], o0[8], o1[8];
        unpack8(*(const v4u*)(rowp + COL_G), gg); unpack8(*(const v4u*)(rowp + COL_SGP), sg);
#pragma unroll
        for (int e = 0; e < 8; ++e) { o0[e] = sg[e] * ps[e] * accp[m][e >> 2][e & 3] + gg[e] * acci[m][e >> 2][e & 3]; o1[e] = gg[e] * accr[m][e >> 2][e & 3]; }
        *(v4u*)(M0 + row * D + ch0) = pack8(o0); *(v4u*)(M1 + row * D + ch0) = pack8(o1); }
    if (fr == 15) { float* pa = ach + (size_t)chunk * D + ch0; float* pb = bch + (size_t)chunk * D + ch0;
        *(f32x4*)pa = accr[3][0]; *(f32x4*)(pa + 4) = accr[3][1]; *(f32x4*)pb = acci[3][0]; *(f32x4*)(pb + 4) = acci[3][1]; }
}

struct Args { const float* in[18]; float* out; unsigned char* ws; int ph_lo, ph_hi, li, pad; };
__global__ void __launch_bounds__(NWAVES * 64, 2) fwd_kernel(Args args) {
    extern __shared__ __attribute__((aligned(16))) unsigned char lds_raw[];
    LAS unsigned char* lds = (LAS unsigned char*)lds_raw;
    volatile LAS unsigned* MISC = (volatile LAS unsigned*)(lds + MISC_OFF);
#define tid (pg8::tid_opaque())
#define lane (pg8::tid_opaque() & 63)
#define wave (__builtin_amdgcn_readfirstlane(pg8::tid_opaque() >> 6))
    const int G = gridDim.x; const int bx = blockIdx.x; const int vcu = (G % 8 == 0) ? (bx % 8) * (G / 8) + bx / 8 : bx;
    unsigned char* ws = args.ws;
    gu32* ctl = (gu32*)(ws + WS_CTL);
    const float* x = args.in[0]; const float* meta = args.in[1]; const float* norm1_g = args.in[2]; const float* w_in = args.in[3];
    const float* pool_w = args.in[4]; const float* pool_scale = args.in[5]; const float* conv_w = args.in[6]; const float* conv_b = args.in[7];
    const float* gate_a_w = args.in[8]; const float* gate_a_b = args.in[9]; const float* gate_x_w = args.in[10]; const float* gate_x_b = args.in[11];
    const float* lru_lambda = args.in[12]; const float* w_out = args.in[13]; const float* norm2_g = args.in[14]; const float* mlp_w1 = args.in[15];
    const float* mlp_w2 = args.in[16]; const float* final_g = args.in[17];
    float* out = args.out;
    bf16* WIN_T = (bf16*)(ws + WS_WIN_T); bf16* WOUT_T = (bf16*)(ws + WS_WOUT_T); bf16* W1_T = (bf16*)(ws + WS_W1_T); bf16* W2_T = (bf16*)(ws + WS_W2_T);
    bf16* POOL_T = (bf16*)(ws + WS_POOL_T); bf16* GATE_T = (bf16*)(ws + WS_GATE_T);
    bf16* PROJ = (bf16*)(ws + WS_PROJ); bf16* ACT = (bf16*)(ws + WS_ACT); bf16* U = (bf16*)(ws + WS_U); bf16* MBUF0 = U;
    bf16* MBUF1 = (bf16*)(ws + WS_XCB); bf16* H1BF = (bf16*)(ws + WS_H1BF); bf16* UMETA = (bf16*)(ws + WS_UMETA);
    float* PROJMETA = (float*)(ws + WS_PROJMETA); float* HMETA = (float*)(ws + WS_HMETA); float* NLS = (float*)(ws + WS_NLS);
    float* ACH = (float*)(ws + WS_ACH); float* BCH = (float*)(ws + WS_BCH); float* CARRY = (float*)(ws + WS_CARRY);
    float* ROWSS1 = (float*)(ws + WS_ROWSS1); float* ROWSS2 = (float*)(ws + WS_ROWSS2);

    for (int u = tid; u < (LDS_BYTES - LDSCTL_OFF) / 4; u += NWAVES * 64) ((LAS unsigned*)(lds + LDSCTL_OFF))[u] = 0u;
    __syncthreads();
    XcdBarrier bar; bar.bar = (unsigned*)(ctl + CW_BAR); bar.x = 0; bar.st = nullptr;
    if (N_LAUNCHES == 1) bar = xcd_barrier_post((unsigned*)(ctl + CW_BAR), MISC + 8);
#define GRID_BAR() do { if (N_LAUNCHES == 1) xcd_barrier(bar); } while (0)
    const int lo = args.ph_lo, hi = args.ph_hi;
#ifndef MK_PHASE_MASK
#define MK_PHASE_MASK 0x1ff
#endif
#ifndef MK_REP_MASK
#define MK_REP_MASK 0
#endif
#define REP(k) for (int rep_ = 0; rep_ < 1 + ((MK_REP_MASK >> (k)) & 1); ++rep_)
#define IN(k) (((MK_PHASE_MASK >> (k)) & 1) && lo <= (k) && (k) < hi)
#define BOTH(k) (IN(k) && IN((k) + 1))
#if MK_SIMPLE_GEMM
#define RUN_GEMM(EpiT, g, S, E) pg8::gemm_simple<EpiT, pg8::StaticOrder>(g, S, E)
#else
#define RUN_GEMM(EpiT, g, S, E) pg8::gemm_phase<EpiT, pg8::StaticOrder, true, true>(lds + RING_OFF, g, S, E)
#endif

    if (IN(0)) { REP(0) {
        LAS float* scr = (LAS float*)(lds + RING_OFF + wave * 16384);
        const int gw = vcu * NWAVES + wave, NGW = G * NWAVES;
        constexpr int I_IN = 32 * 320, I_OUT = 32 * 64, I_1 = 32 * 256, I_2 = 128 * 64, I_P = 4 * 8 * 16, I_G = 2 * 8 * 4 * 8;
        constexpr int NITEMS = I_IN + I_OUT + I_1 + I_2 + I_P + I_G;
        for (int it = gw; it < NITEMS; it += NGW) {
            int r = it;
            if (r < I_IN) { const int kb = r / 320, nb = r % 320, n0 = 32 * nb; int dr = n0;
                if (n0 >= 4 * D) { const int ch = n0 - 4 * D; dr = 256 * (16 + (ch >> 7)) + 128 + (ch & 127); }
                else if (n0 >= 3 * D) dr = 4 * D + (n0 - 3 * D);
                else if (n0 >= 2 * D) { const int ch = n0 - 2 * D; dr = 256 * (16 + (ch >> 7)) + (ch & 127); }
                p0_tr_item(w_in, INC, 64 * kb, n0, WIN_T, D, dr, nullptr, scr, lane); continue; } r -= I_IN;
            if (r < I_OUT) { const int kb = r / 64, nb = r % 64; p0_tr_item(w_out, D, 64 * kb, 32 * nb, WOUT_T, D, 32 * nb, nullptr, scr, lane); continue; } r -= I_OUT;
            if (r < I_1) { const int kb = r / 256, nb = r % 256; p0_tr_item(mlp_w1, DFF, 64 * kb, 32 * nb, W1_T, D, 32 * nb, norm2_g, scr, lane); continue; } r -= I_1;
            if (r < I_2) { const int kb = r / 64, nb = r % 64; p0_tr_item(mlp_w2, D, 64 * kb, 32 * nb, W2_T, DFF, 32 * nb, nullptr, scr, lane); continue; } r -= I_2;
            if (r < I_P) { const int g = r / 128, q = r % 128, kb = q / 16, nb = q % 16; p0_tr_item(pool_w + (size_t)g * 512 * 512, 512, 64 * kb, 32 * nb, POOL_T, 512, 512 * g + 32 * nb, nullptr, scr, lane); continue; } r -= I_P;
            { const int gate = r / 256, q = r % 256, h = q / 32, q2 = q % 32, kb = q2 / 8, nb = q2 % 8, j0 = 32 * nb;
              p0_tr_item((gate ? gate_x_w : gate_a_w) + (size_t)h * 65536, 256, 64 * kb, j0, GATE_T, 256, D * gate + 256 * h + j0, nullptr, scr, lane); }
        }
        for (int m = gw; m < MR + NMETA; m += NGW) {
            if (m < MR) rms_row_to_bf16(x + (size_t)m * D, norm1_g, U + (size_t)m * D, lane);
            else rms_row_to_bf16(meta + (size_t)(m - MR) * D, norm1_g, UMETA + (size_t)(m - MR) * D, lane);
        }
        if (bx == 0) for (int c = tid; c < D; c += NWAVES * 64) NLS[c] = -8.f * log1pf(expf(-lru_lambda[c]));
        }
        if (BOTH(0)) GRID_BAR();
    }

    if (IN(1)) {
        REP(1) { pg8::Gemm g{U, WIN_T, D, D, 1 << 30}; pg8::StaticOrder S; S.init(MR, INC, G, bx); EpiProj E{PROJ};
          RUN_GEMM(EpiProj, g, S, E); }
        __syncthreads();
        for (int nb = bx; nb < 256; nb += G) {
            const int fr = lane & 15, fq = lane >> 4, n0 = 16 * nb;
            f32x4 acc = (f32x4){0.f, 0.f, 0.f, 0.f};
#pragma unroll
            for (int kk = 0; kk < 8; ++kk) { const int k = 256 * wave + 32 * kk + 8 * fq;
                const bf16x8 a = *(const bf16x8*)(UMETA + (size_t)fr * D + k), b = *(const bf16x8*)(WIN_T + (size_t)(n0 + fr) * D + k);
                acc = __builtin_amdgcn_mfma_f32_16x16x32_bf16(a, b, acc, 0, 0, 0); }
            LAS f32x4* red = (LAS f32x4*)(lds + RING_OFF);
            red[wave * 64 + lane] = acc;
            __syncthreads();
            if (wave == 0) { f32x4 s = red[lane];
#pragma unroll
                for (int w = 1; w < 8; ++w) s += red[w * 64 + lane];
#pragma unroll
                for (int r = 0; r < 4; ++r) PROJMETA[(size_t)(4 * fq + r) * (2 * D) + n0 + fr] = s[r]; }
            __syncthreads();
        }
        if (BOTH(1)) GRID_BAR();
    }

    if (IN(2)) {
        for (int t = bx; t < NCHUNK * 8; t += G) {
            const int s = t & 7, chunk = t >> 3, g = s >> 1, b = chunk >> 6, tl0 = (chunk & 63) * 64;
            { const int tt = tid;
              if (g == 0) build_d<2>(PROJ, PROJMETA, lds, b, tl0, g, tt); else if (g == 1) build_d<4>(PROJ, PROJMETA, lds, b, tl0, g, tt);
              else if (g == 2) build_d<8>(PROJ, PROJMETA, lds, b, tl0, g, tt); else build_d<16>(PROJ, PROJMETA, lds, b, tl0, g, tt);
              build_xc(PROJ, PROJMETA, conv_w, conv_b, lds, b, tl0, s, tt); }
            __syncthreads();
            { const int wv = wave; mixer_wave(lds, POOL_T, GATE_T, PROJ, pool_scale, gate_a_b, gate_x_b, NLS, MBUF0, MBUF1, ACH, BCH, chunk, 256 * s + 32 * wv, wv, lane); }
            __syncthreads();
        }
        for (int h = bx; h < 8; h += G) {
            LAS float* xs = (LAS float*)(lds + RING_OFF);
            LAS float* rg = (LAS float*)(lds + RING_OFF + 16384);
            for (int i = tid; i < 16 * 256; i += NWAVES * 64) { const int p = i >> 8, c = 256 * h + (i & 255); float sx = conv_b[c];
                for (int k = 0; k < 4; ++k) { const int q = p - 3 + k; if (q >= 0) sx += conv_w[k * D + c] * PROJMETA[(size_t)q * (2 * D) + D + c]; }
                xs[i] = sx; }
            __syncthreads();
            const int j = tid & 255, gate = tid >> 8;
            const float* W = (gate ? gate_x_w : gate_a_w) + (size_t)h * 65536;
            const float bias = (gate ? gate_x_b : gate_a_b)[256 * h + j];
            float a16[16];
#pragma unroll
            for (int p = 0; p < 16; ++p) a16[p] = bias;
            for (int i = 0; i < 256; ++i) { const float wv = W[i * 256 + j];
#pragma unroll
                for (int p = 0; p < 16; ++p) a16[p] += xs[p * 256 + i] * wv; }
#pragma unroll
            for (int p = 0; p < 16; ++p) rg[(gate * 16 + p) * 256 + j] = sigm(a16[p]);
            __syncthreads();
            if (tid < 256) { const int tt = tid; const int ch = 256 * h + tt; const float nl = NLS[ch]; float hh = 0.f;
                for (int p = 0; p < 16; ++p) { const float r = rg[p * 256 + tt], ig = rg[(16 + p) * 256 + tt], la = nl * r, a = expf(la), mult = sqrtf(-expm1f(2.f * la));
                    hh = a * hh + mult * ig * xs[p * 256 + tt]; }
                HMETA[ch] = hh; }
            __syncthreads();
        }
        if (BOTH(2)) GRID_BAR();
    }

    if (IN(3)) {
        const int gid = bx * (NWAVES * 64) + tid;
        if (gid < BATCH * D) { const int b = gid >> 11, c = gid & (D - 1); float carry = HMETA[c];
#pragma unroll 8
            for (int k = 0; k < 64; ++k) { const size_t o = (size_t)(b * 64 + k) * D + c; CARRY[o] = carry; carry = ACH[o] * carry + BCH[o]; } }
        if (BOTH(3)) GRID_BAR();
    }

    if (IN(4)) {
        const int gw = vcu * NWAVES + wave, NGW = G * NWAVES, ln = lane;
        for (int m0 = 4 * gw; m0 < MR; m0 += 4 * NGW) {
#pragma unroll
            for (int r = 0; r < 4; ++r) { const int m = m0 + r; const float* cr = CARRY + (size_t)(m >> 6) * D;
#pragma unroll
                for (int q = 0; q < 4; ++q) { const int c = 512 * q + 8 * ln; float a0[8], a1[8], o[8];
                    unpack8(*(const v4u*)(MBUF0 + (size_t)m * D + c), a0); unpack8(*(const v4u*)(MBUF1 + (size_t)m * D + c), a1);
                    const f32x4 c0 = *(const f32x4*)(cr + c), c1 = *(const f32x4*)(cr + c + 4);
#pragma unroll
                    for (int e = 0; e < 8; ++e) o[e] = a0[e] + a1[e] * (e < 4 ? c0[e & 3] : c1[e & 3]);
                    *(v4u*)(MBUF0 + (size_t)m * D + c) = pack8(o); } } }
        if (BOTH(4)) GRID_BAR();
    }

    if (IN(5)) {
        { pg8::Gemm g{MBUF0, WOUT_T, D, D, 1 << 30}; pg8::StaticOrder S; S.init(MR, D, G, bx); EpiH1 E{x, out, H1BF, ROWSS1};
          RUN_GEMM(EpiH1, g, S, E); }
        if (BOTH(5)) GRID_BAR();
    }
    if (IN(6)) {
        REP(6) { pg8::Gemm g{H1BF, W1_T, D, D, 1 << 30}; pg8::StaticOrder S; S.init(MR, DFF, G, bx); EpiAct E{ACT, ROWSS1};
          RUN_GEMM(EpiAct, g, S, E); }
        if (BOTH(6)) GRID_BAR();
    }
    if (IN(7)) {
        { pg8::Gemm g{ACT, W2_T, DFF, DFF, 1 << 30}; pg8::StaticOrder S; S.init(MR, D, G, bx); EpiOut E{out, ROWSS2};
          RUN_GEMM(EpiOut, g, S, E); }
        if (BOTH(7)) GRID_BAR();
    }
    if (IN(8)) {
        const int gw = vcu * NWAVES + wave, NGW = G * NWAVES;
        for (int m = gw; m < MR; m += NGW) { const float rs = rsqrtf(ROWSS2[m] * (1.f / D) + NORM_EPS); f32x4* orow = (f32x4*)(out + (size_t)m * D) + lane; const f32x4* gr = (const f32x4*)final_g + lane;
#pragma unroll
            for (int j = 0; j < 8; ++j) { f32x4 v = orow[64 * j]; const f32x4 gg = gr[64 * j]; v = v * rs * gg; orow[64 * j] = v; } }
    }
#undef IN
#undef BOTH
#undef tid
#undef lane
#undef wave
}

extern "C" void kernel_launch(void* const* d_in, const int* in_sizes, int n_in, void* d_out, int out_size, void* d_ws, size_t ws_size, hipStream_t stream) {
    static int grid = 0;
    if (grid == 0) {
        if (n_in != 18 || in_sizes[0] != MR * D || out_size != MR * D || ws_size < WS_END) { fprintf(stderr, "kernel_launch: unexpected shapes or workspace (n_in %d, ws %zu)\n", n_in, ws_size); grid = -1; return; }
        int dev = 0, cus = 0;
        if (hipGetDevice(&dev) != hipSuccess || hipDeviceGetAttribute(&cus, hipDeviceAttributeMultiprocessorCount, dev) != hipSuccess) { grid = -1; return; }
        if (hipFuncSetAttribute((const void*)fwd_kernel, hipFuncAttributeMaxDynamicSharedMemorySize, LDS_BYTES) != hipSuccess) { grid = -1; return; }
        (void)hipGetLastError();
        grid = cus;
    }
    if (grid < 0) return;
    (void)hipMemsetAsync((char*)d_ws + WS_CTL, 0, CTL_ZERO_BYTES, stream);
    Args a{};
    for (int i = 0; i < 18; ++i) a.in[i] = (const float*)d_in[i];
    a.out = (float*)d_out; a.ws = (unsigned char*)d_ws;
    if (N_LAUNCHES == 1) { a.ph_lo = 0; a.ph_hi = NPHASES; a.li = 0; hipLaunchKernelGGL(fwd_kernel, dim3(grid), dim3(NWAVES * 64), LDS_BYTES, stream, a); }
    else for (int li = 0; li < NPHASES; ++li) { a.ph_lo = li; a.ph_hi = li + 1; a.li = li; hipLaunchKernelGGL(fwd_kernel, dim3(grid), dim3(NWAVES * 64), LDS_BYTES, stream, a); }
}
```

```cpp
#include <hip/hip_runtime.h>
#include <cstdio>
#include <cstdint>

#ifndef MK_N_LAUNCHES
#define MK_N_LAUNCHES 1
#endif
#ifndef MK_SIMPLE_GEMM
#define MK_SIMPLE_GEMM 0
#endif

namespace pg8 {
#define PG8_LAS __attribute__((address_space(3)))
typedef unsigned short bf16_t;
typedef short bf16x8 __attribute__((ext_vector_type(8)));
typedef float f32x4 __attribute__((ext_vector_type(4)));
typedef unsigned u32x4 __attribute__((ext_vector_type(4)));
typedef unsigned u32x2 __attribute__((ext_vector_type(2)));
constexpr int BM = 256, BK = 64, HALF = 128, HTB = HALF * BK * 2  , STAGE_BYTES = 8 * HTB, NXCD = 8, WGM = 8;

__host__ __device__ __forceinline__ int lds_byte(int r, int c) { const int st = (r >> 4) * 2 + (c >> 5), rr = r & 15, cc = c & 31, ob = rr * 64 + cc * 2; return st * 1024 + (ob ^ (((ob >> 9) & 1) << 5)); }
__host__ __device__ __forceinline__ void stage_rc(int b, int& R, int& C) { const int st = b / 1024, sb = b % 1024, swz = sb ^ (((sb >> 9) & 1) << 5); R = (st >> 1) * 16 + swz / 64; C = (st & 1) * 32 + (swz % 64) / 2; }
__host__ __device__ __forceinline__ int perm32(int rho) { const int n = rho >> 4, i = rho & 15; return 8 * (i >> 2) + 4 * n + (i & 3); }

__device__ __forceinline__ int tid_opaque() { int t = (int)threadIdx.x; asm volatile("" : "+v"(t)); return t; }
struct Unit { int pm, pn; };
struct Gemm { const bf16_t* A; const bf16_t* Bt; int lda, K, tpg; };

struct StaticOrder {
    int nM, nN, nwg, G, c;
    __host__ __device__ void init(int M, int N, int G_, int c_) { nM = M / BM; nN = N / BM; nwg = nM * nN; G = G_; c = c_; }
    __host__ __device__ bool next(int i, Unit& u) const {
        const long L = (long)i * G + c; if (L >= nwg) return false;
        int wgid = (int)L; { const int q = nwg / NXCD, r = nwg % NXCD, xcd = wgid % NXCD, off = wgid / NXCD; wgid = (xcd < r ? xcd * (q + 1) : r * (q + 1) + (xcd - r) * q) + off; }
        const int nig = WGM * nN, gid = wgid / nig, fm = gid * WGM, gsz = (nM - fm) < WGM ? (nM - fm) : WGM;
        u.pm = fm + ((wgid % nig) % gsz); u.pn = (wgid % nig) / gsz; return true;
    }
    __device__ __forceinline__ void a_ready(const Unit&) const {}
    __device__ __forceinline__ void done(const Unit&) const {}
};

__device__ __forceinline__ unsigned cvt_pk_bf16(float lo, float hi) { unsigned r; asm volatile("v_cvt_pk_bf16_f32 %0, %1, %2" : "=v"(r) : "v"(lo), "v"(hi)); return r; }

template <class Epi, class Sched, bool ALIGN_EPI = false, bool SP2 = false>
__device__ __forceinline__ void gemm_phase(PG8_LAS unsigned char* lds, const Gemm g, const Sched& S, const Epi& E) {
    const int tid = tid_opaque(), wid = __builtin_amdgcn_readfirstlane(tid >> 6), lane = tid & 63, wr = wid >> 2, wc = wid & 3, fr = lane & 15, fq = lane >> 4;
    const int K = g.K, nt = K / BK, lda = g.lda;
    unsigned voffA[2], voffB[2];
#pragma unroll
    for (int i = 0; i < 2; ++i) { int R, C; stage_rc(tid * 16 + i * 8192, R, C); const int Rb = Epi::PERM ? ((R & ~31) + perm32(R & 31)) : R;
        voffA[i] = (unsigned)(R * lda + C) * 2u; voffB[i] = (unsigned)(Rb * K + C) * 2u; }
    const size_t kstep = (size_t)(BK * 2);
    const size_t hstepA = (size_t)HALF * lda * 2, hstepB = (size_t)HALF * K * 2;
    const size_t tstepA = 2 * hstepA, tstepB = 2 * hstepB;
    const unsigned ldsw = (unsigned)wid * 1024u;
    const int aoff = lds_byte(wr * 64 + fr, fq * 8), boff = lds_byte(wc * 32 + fr, fq * 8);
#define PG8_SA(b, h) (((b) * 2 + (h)) * HTB)
#define PG8_SB(b, h) ((4 + (b) * 2 + (h)) * HTB)
#define PG8_STAGE(bufoff, gbase, voff) do { _Pragma("unroll") for (int _i = 0; _i < 2; ++_i) \
        __builtin_amdgcn_global_load_lds((const unsigned*)((const char*)(gbase) + (voff)[_i]), (PG8_LAS unsigned*)(lds + (bufoff) + ldsw + _i * 8192), 16, 0, 0); } while (0)
#define PG8_LDA(dst, b, h) do { _Pragma("unroll") for (int m = 0; m < 4; ++m) _Pragma("unroll") for (int k = 0; k < 2; ++k) dst[m][k] = *(const PG8_LAS bf16x8*)(lds + PG8_SA(b, h) + aoff + m * 2048 + k * 1024); } while (0)
#define PG8_LDB(dst, b, h) do { _Pragma("unroll") for (int n = 0; n < 2; ++n) _Pragma("unroll") for (int k = 0; k < 2; ++k) dst[n][k] = *(const PG8_LAS bf16x8*)(lds + PG8_SB(b, h) + boff + n * 2048 + k * 1024); } while (0)
#define PG8_MMA(ai, bj, At, Bt) do { __builtin_amdgcn_s_setprio(1); _Pragma("unroll") for (int m = 0; m < 4; ++m) _Pragma("unroll") for (int n = 0; n < 2; ++n) _Pragma("unroll") for (int k = 0; k < 2; ++k) \
        acc[ai][bj][m][n] = __builtin_amdgcn_mfma_f32_16x16x32_bf16(Bt[n][k], At[m][k], acc[ai][bj][m][n], 0, 0, 0); __builtin_amdgcn_s_setprio(0); } while (0)
#define PG8_WAIT_V(n) asm volatile("s_waitcnt vmcnt(" #n ")" ::: "memory")
#define PG8_WAIT_L(n) asm volatile("s_waitcnt lgkmcnt(" #n ")" ::: "memory")
#define PG8_BAR __builtin_amdgcn_s_barrier()
#define PG8_SCHED __builtin_amdgcn_sched_barrier(0)
    Unit cur, nxt; int ui = 0;
    if (!S.next(0, cur)) return;
    f32x4 acc[2][2][4][2];
#pragma unroll
    for (int a = 0; a < 2; ++a)
#pragma unroll
        for (int b = 0; b < 2; ++b)
#pragma unroll
            for (int m = 0; m < 4; ++m)
#pragma unroll
                for (int n = 0; n < 2; ++n) acc[a][b][m][n] = (f32x4){0.f, 0.f, 0.f, 0.f};
    bf16x8 At[4][2], B0[2][2], B1[2][2];
    const char* cA = (const char*)g.A + (size_t)cur.pm * tstepA + (size_t)(cur.pn / g.tpg) * K * 2; const char* cB = (const char*)g.Bt + (size_t)cur.pn * tstepB;
    S.a_ready(cur);
    if constexpr (SP2) {
        PG8_STAGE(PG8_SB(0, 0), cB, voffB); PG8_STAGE(PG8_SB(0, 1), cB + hstepB, voffB); PG8_STAGE(PG8_SA(0, 0), cA, voffA); PG8_STAGE(PG8_SA(0, 1), cA + hstepA, voffA);
        if (wr == 1) PG8_BAR;
        PG8_WAIT_V(2); PG8_BAR;
        PG8_STAGE(PG8_SB(1, 0), cB + kstep, voffB); PG8_STAGE(PG8_SA(1, 0), cA + kstep, voffA); PG8_STAGE(PG8_SB(1, 1), cB + hstepB + kstep, voffB);
        PG8_WAIT_V(6); PG8_BAR;
    } else {
        PG8_STAGE(PG8_SB(0, 0), cB, voffB); PG8_STAGE(PG8_SA(0, 0), cA, voffA); PG8_STAGE(PG8_SB(0, 1), cB + hstepB, voffB); PG8_STAGE(PG8_SA(0, 1), cA + hstepA, voffA);
        if (wr == 1) PG8_BAR;
        PG8_WAIT_V(4); PG8_BAR;
        PG8_STAGE(PG8_SB(1, 0), cB + kstep, voffB); PG8_STAGE(PG8_SA(1, 0), cA + kstep, voffA); PG8_STAGE(PG8_SB(1, 1), cB + hstepB + kstep, voffB);
        PG8_WAIT_V(6); PG8_BAR;
    }
    for (;;) {
        const bool has_next = S.next(ui + 1, nxt);
        const char* nA = has_next ? (const char*)g.A + (size_t)nxt.pm * tstepA + (size_t)(nxt.pn / g.tpg) * K * 2 : cA; const char* nB = has_next ? (const char*)g.Bt + (size_t)nxt.pn * tstepB : cB;
        for (int t = 0; t < nt; t += 2) {
            const bool last = (t == nt - 2);
            const char* a1 = cA + (size_t)(t + 1) * kstep;
            const char* a2 = last ? nA : cA + (size_t)(t + 2) * kstep; const char* b2 = last ? nB : cB + (size_t)(t + 2) * kstep;
            const char* a3 = a2 + kstep; const char* b3 = b2 + kstep;
            if (last && has_next) S.a_ready(nxt);
            if constexpr (SP2) {
            PG8_LDB(B0, 0, 0); PG8_LDB(B1, 0, 1); PG8_SCHED; PG8_LDA(At, 0, 0); PG8_STAGE(PG8_SA(1, 1), a1 + hstepA, voffA);
            PG8_WAIT_V(8); PG8_WAIT_L(0); PG8_BAR; PG8_MMA(0, 0, At, B0); PG8_MMA(0, 1, At, B1); PG8_BAR; PG8_SCHED;
            PG8_LDA(At, 0, 1); PG8_STAGE(PG8_SB(0, 0), b2, voffB); PG8_STAGE(PG8_SB(0, 1), b2 + hstepB, voffB); PG8_STAGE(PG8_SA(0, 0), a2, voffA);
            PG8_WAIT_V(8); PG8_WAIT_L(0); PG8_BAR; PG8_MMA(1, 0, At, B0); PG8_MMA(1, 1, At, B1); PG8_BAR; PG8_SCHED;
            PG8_LDB(B0, 1, 0); PG8_LDB(B1, 1, 1); PG8_SCHED; PG8_LDA(At, 1, 0); PG8_STAGE(PG8_SA(0, 1), a2 + hstepA, voffA);
            PG8_WAIT_V(8); PG8_WAIT_L(0); PG8_BAR; PG8_MMA(0, 0, At, B0); PG8_MMA(0, 1, At, B1); PG8_BAR; PG8_SCHED;
            PG8_LDA(At, 1, 1); PG8_STAGE(PG8_SB(1, 0), b3, voffB); PG8_STAGE(PG8_SB(1, 1), b3 + hstepB, voffB); PG8_STAGE(PG8_SA(1, 0), a3, voffA);
            PG8_WAIT_V(8); PG8_WAIT_L(0); PG8_BAR; PG8_MMA(1, 0, At, B0); PG8_MMA(1, 1, At, B1); PG8_BAR; PG8_SCHED;
            } else {
            PG8_LDB(B0, 0, 0); PG8_SCHED; PG8_LDA(At, 0, 0); PG8_STAGE(PG8_SA(1, 1), a1 + hstepA, voffA);
            PG8_WAIT_L(8); PG8_BAR; PG8_WAIT_L(0); PG8_MMA(0, 0, At, B0); PG8_BAR; PG8_SCHED;
            PG8_LDB(B1, 0, 1); PG8_STAGE(PG8_SB(0, 0), b2, voffB);
            PG8_BAR; PG8_WAIT_L(0); PG8_MMA(0, 1, At, B1); PG8_BAR;
            PG8_LDA(At, 0, 1); PG8_STAGE(PG8_SA(0, 0), a2, voffA);
            PG8_BAR; PG8_WAIT_L(0); PG8_MMA(1, 0, At, B0); PG8_BAR; PG8_SCHED;
            PG8_STAGE(PG8_SB(0, 1), b2 + hstepB, voffB);
            PG8_WAIT_V(6); PG8_BAR; PG8_MMA(1, 1, At, B1); PG8_BAR;
            PG8_LDB(B0, 1, 0); PG8_SCHED; PG8_LDA(At, 1, 0); PG8_STAGE(PG8_SA(0, 1), a2 + hstepA, voffA);
            PG8_WAIT_L(8); PG8_BAR; PG8_WAIT_L(0); PG8_MMA(0, 0, At, B0); PG8_BAR; PG8_SCHED;
            PG8_LDB(B1, 1, 1); PG8_STAGE(PG8_SB(1, 0), b3, voffB);
            PG8_BAR; PG8_WAIT_L(0); PG8_MMA(0, 1, At, B1); PG8_BAR;
            PG8_LDA(At, 1, 1); PG8_STAGE(PG8_SA(1, 0), a3, voffA);
            PG8_BAR; PG8_WAIT_L(0); PG8_MMA(1, 0, At, B0); PG8_BAR; PG8_SCHED;
            PG8_STAGE(PG8_SB(1, 1), b3 + hstepB, voffB);
            PG8_WAIT_V(6); PG8_BAR; PG8_MMA(1, 1, At, B1); PG8_BAR;
            }
        }
        if constexpr (ALIGN_EPI) { if (wr == 0) PG8_BAR; }
        E(acc, cur, wr, wc, fr, fq); S.done(cur);
        if (!has_next) break;
#pragma unroll
        for (int a = 0; a < 2; ++a)
#pragma unroll
            for (int b = 0; b < 2; ++b)
#pragma unroll
                for (int m = 0; m < 4; ++m)
#pragma unroll
                    for (int n = 0; n < 2; ++n) acc[a][b][m][n] = (f32x4){0.f, 0.f, 0.f, 0.f};
        cur = nxt; cA = nA; cB = nB; ++ui;
        if constexpr (ALIGN_EPI) { if (wr == 1) PG8_BAR; }
    }
    PG8_WAIT_V(0);
    if constexpr (!ALIGN_EPI) { if (wr == 0) PG8_BAR; }
    PG8_BAR;
#undef PG8_SA
#undef PG8_SB
#undef PG8_STAGE
#undef PG8_LDA
#undef PG8_LDB
#undef PG8_MMA
#undef PG8_WAIT_V
#undef PG8_WAIT_L
#undef PG8_BAR
#undef PG8_SCHED
}

template <class Epi, class Sched>
__device__ __forceinline__ void gemm_simple(const Gemm g, const Sched& S, const Epi& E) {
    const int tid = tid_opaque(), wid = __builtin_amdgcn_readfirstlane(tid >> 6), lane = tid & 63, wr = wid >> 2, wc = wid & 3, fr = lane & 15, fq = lane >> 4;
    Unit cur;
    for (int ui = 0; S.next(ui, cur); ++ui) {
        f32x4 acc[2][2][4][2];
#pragma unroll
        for (int a = 0; a < 2; ++a)
#pragma unroll
            for (int b = 0; b < 2; ++b)
#pragma unroll
                for (int m = 0; m < 4; ++m)
#pragma unroll
                    for (int n = 0; n < 2; ++n) acc[a][b][m][n] = (f32x4){0.f, 0.f, 0.f, 0.f};
        const bf16_t* Ab = g.A + (size_t)cur.pm * 256 * g.lda + (size_t)(cur.pn / g.tpg) * g.K;
        const bf16_t* Bb = g.Bt + (size_t)cur.pn * 256 * g.K;
        for (int k0 = 0; k0 < g.K; k0 += 32) {
            bf16x8 a[2][4], b[2][2];
#pragma unroll
            for (int ai = 0; ai < 2; ++ai)
#pragma unroll
                for (int m = 0; m < 4; ++m) a[ai][m] = *(const bf16x8*)(Ab + (size_t)(128 * ai + 64 * wr + 16 * m + fr) * g.lda + k0 + 8 * fq);
#pragma unroll
            for (int bj = 0; bj < 2; ++bj)
#pragma unroll
                for (int n = 0; n < 2; ++n) { const int slot = 16 * n + fr; const int rr = Epi::PERM ? perm32(slot) : slot;
                    b[bj][n] = *(const bf16x8*)(Bb + (size_t)(128 * bj + 32 * wc + rr) * g.K + k0 + 8 * fq); }
#pragma unroll
            for (int ai = 0; ai < 2; ++ai)
#pragma unroll
                for (int bj = 0; bj < 2; ++bj)
#pragma unroll
                    for (int m = 0; m < 4; ++m)
#pragma unroll
                        for (int n = 0; n < 2; ++n) acc[ai][bj][m][n] = __builtin_amdgcn_mfma_f32_16x16x32_bf16(b[bj][n], a[ai][m], acc[ai][bj][m][n], 0, 0, 0);
        }
        E(acc, cur, wr, wc, fr, fq);
    }
    __syncthreads();
}
}

constexpr int NWAVES = 8;
constexpr int N_LAUNCHES = MK_N_LAUNCHES;
constexpr int NPHASES = 9;
constexpr int D = 2048, SEQ = 4096, BATCH = 2, NMETA = 16, MR = BATCH * SEQ, INC = 5 * D, DFF = 4 * D;
constexpr int NCHUNK = MR / 64;
constexpr float NORM_EPS = 1e-6f;
constexpr int PST = 4 * D;
constexpr int PROWS = NMETA + SEQ;
__device__ __forceinline__ size_t prow(int m) { return (size_t)m + NMETA * ((m >> 12) + 1); }
constexpr int COL_VPOOL = 0, COL_VLRU = D, COL_G = 2 * D, COL_SGP = 3 * D;

constexpr size_t MiB = 1u << 20;
constexpr size_t WS_CTL = 0, CTL_ZERO_BYTES = 1 * MiB;
constexpr size_t WS_ROWSS1 = 256 * 1024, WS_ROWSS2 = 320 * 1024;
constexpr size_t WS_WIN_T = 1 * MiB;
constexpr size_t WS_XCB = WS_WIN_T, WS_H1BF = WS_WIN_T;
constexpr size_t WS_WOUT_T = 41 * MiB;
constexpr size_t WS_W1_T = 49 * MiB;
constexpr size_t WS_W2_T = 81 * MiB;
constexpr size_t WS_POOL_T = 113 * MiB;
constexpr size_t WS_GATE_T = 115 * MiB;
constexpr size_t WS_PROJ = 117 * MiB;
constexpr size_t WS_ACT = WS_PROJ;
constexpr size_t WS_U = 277 * MiB;
constexpr size_t WS_SMALL = 309 * MiB;
constexpr size_t WS_UMETA = WS_SMALL;
constexpr size_t WS_PROJMETA = WS_SMALL + 64 * 1024;
constexpr size_t WS_XCMETA = WS_SMALL + 320 * 1024;
constexpr size_t WS_HMETA = WS_SMALL + 448 * 1024;
constexpr size_t WS_NLS = WS_SMALL + 456 * 1024;
constexpr size_t WS_ACH = WS_SMALL + 1 * MiB;
constexpr size_t WS_BCH = WS_SMALL + 2 * MiB;
constexpr size_t WS_CARRY = WS_SMALL + 3 * MiB;
constexpr size_t WS_END = 313 * MiB;
constexpr int CW_TMO = 0, CW_BAR = 4096;

constexpr int RING_OFF = 0, RING_BYTES = 131072;
constexpr int LDSCTL_OFF = RING_BYTES, MISC_OFF = LDSCTL_OFF + 320;
constexpr int LDS_BYTES = 147456;

#define GAS __attribute__((address_space(1)))
#define LAS __attribute__((address_space(3)))
typedef unsigned short bf16;
typedef unsigned v4u __attribute__((ext_vector_type(4)));
typedef unsigned v2u __attribute__((ext_vector_type(2)));
typedef float f32x4 __attribute__((ext_vector_type(4)));
typedef short bf16x8 __attribute__((ext_vector_type(8)));
typedef GAS unsigned gu32;
#define RLX_AGENT __ATOMIC_RELAXED, __HIP_MEMORY_SCOPE_AGENT
#define LDS_WAIT() asm volatile("s_waitcnt lgkmcnt(0)" ::: "memory")
#define VM_WAIT() asm volatile("s_waitcnt vmcnt(0)" ::: "memory")
__device__ __forceinline__ unsigned f2bf(float f) { unsigned u = __builtin_bit_cast(unsigned, f); return (u + 0x7fffu + ((u >> 16) & 1u)) >> 16; }
__device__ __forceinline__ unsigned pk2(float lo, float hi) { return f2bf(lo) | (f2bf(hi) << 16); }
__device__ __forceinline__ float bflo(unsigned w) { return __builtin_bit_cast(float, w << 16); }
__device__ __forceinline__ float bfhi(unsigned w) { return __builtin_bit_cast(float, w & 0xffff0000u); }
__device__ __forceinline__ void unpack8(v4u w, float (&f)[8]) { f[0] = bflo(w.x); f[1] = bfhi(w.x); f[2] = bflo(w.y); f[3] = bfhi(w.y); f[4] = bflo(w.z); f[5] = bfhi(w.z); f[6] = bflo(w.w); f[7] = bfhi(w.w); }
__device__ __forceinline__ v4u pack8(const float (&f)[8]) { v4u w; w.x = pg8::cvt_pk_bf16(f[0], f[1]); w.y = pg8::cvt_pk_bf16(f[2], f[3]); w.z = pg8::cvt_pk_bf16(f[4], f[5]); w.w = pg8::cvt_pk_bf16(f[6], f[7]); return w; }
__device__ __forceinline__ float sigm(float z) { return __builtin_amdgcn_rcpf(1.f + __builtin_amdgcn_exp2f(-1.4426950408889634f * z)); }
__device__ __forceinline__ float expm1_neg(float x) {
    float p = 1.f / 5040.f; p = p * x + 1.f / 720.f; p = p * x + 1.f / 120.f; p = p * x + 1.f / 24.f; p = p * x + 1.f / 6.f; p = p * x + 0.5f; p = p * x + 1.f; p = p * x;
    const float q = __builtin_amdgcn_exp2f(1.4426950408889634f * x) - 1.f;
    return x > -0.25f ? p : q;
}
__device__ __forceinline__ float gelu_tanh(float x) { return x * sigm(1.5957691216057308f * (x + 0.044715f * x * x * x)); }
template <int S> __device__ __forceinline__ float dpp_shr(float oldv, float src) {
    return __builtin_bit_cast(float, __builtin_amdgcn_update_dpp(__builtin_bit_cast(int, oldv), __builtin_bit_cast(int, src), 0x110 + S, 0xf, 0xf, false));
}

typedef f32x4 AccT[2][2][4][2];
struct EpiProj {
    static constexpr bool PERM = true;
    bf16* O;
    __device__ __forceinline__ void operator()(AccT& acc, const pg8::Unit& u, int wr, int wc, int fr, int fq) const {
        const int row0 = u.pm * 256 + wr * 64 + fr + NMETA * ((u.pm >> 4) + 1);
        if (u.pn >= 16 && u.pn < 32) {
            const int col0 = COL_G + (u.pn - 16) * 128 + wc * 32 + 8 * fq;
#pragma unroll
            for (int ai = 0; ai < 2; ++ai)
#pragma unroll
                for (int m = 0; m < 4; ++m) { float o[8];
#pragma unroll
                    for (int e = 0; e < 8; ++e) o[e] = sigm(acc[ai][1][m][e >> 2][e & 3]) * gelu_tanh(acc[ai][0][m][e >> 2][e & 3]);
                    *(v4u*)(O + (size_t)(row0 + ai * 128 + m * 16) * PST + col0) = pack8(o); }
        } else {
            const bool sg = u.pn >= 32; const int col0 = (sg ? COL_SGP + (u.pn - 32) * 256 : u.pn * 256) + wc * 32 + 8 * fq;
#pragma unroll
            for (int ai = 0; ai < 2; ++ai)
#pragma unroll
                for (int m = 0; m < 4; ++m) { bf16* rowp = O + (size_t)(row0 + ai * 128 + m * 16) * PST + col0;
#pragma unroll
                    for (int bj = 0; bj < 2; ++bj) { float o[8];
#pragma unroll
                        for (int e = 0; e < 8; ++e) { const float v = acc[ai][bj][m][e >> 2][e & 3]; o[e] = sg ? sigm(v) : v; }
                        *(v4u*)(rowp + bj * 128) = pack8(o); } }
        }
    }
};
struct EpiH1 {
    static constexpr bool PERM = false;
    const float* x; float* out; bf16* h1bf; float* rowss;
    __device__ __forceinline__ void operator()(AccT& acc, const pg8::Unit& u, int wr, int wc, int fr, int fq) const {
        const int row0 = u.pm * 256 + wr * 64 + fr, col0 = u.pn * 256 + wc * 32 + 4 * fq;
#pragma unroll
        for (int ai = 0; ai < 2; ++ai)
#pragma unroll
            for (int m = 0; m < 4; ++m) { const int row = row0 + ai * 128 + m * 16; const size_t off = (size_t)row * D + col0; float ss = 0.f;
#pragma unroll
                for (int bj = 0; bj < 2; ++bj)
#pragma unroll
                    for (int n = 0; n < 2; ++n) { const f32x4 h = *(const f32x4*)(x + off + bj * 128 + n * 16) + acc[ai][bj][m][n];
                        *(f32x4*)(out + off + bj * 128 + n * 16) = h; ss += (h[0] * h[0] + h[1] * h[1]) + (h[2] * h[2] + h[3] * h[3]);
                        v2u w; w.x = pg8::cvt_pk_bf16(h[0], h[1]); w.y = pg8::cvt_pk_bf16(h[2], h[3]); *(v2u*)(h1bf + off + bj * 128 + n * 16) = w; }
                ss += __shfl_xor(ss, 16); ss += __shfl_xor(ss, 32);
                if (fq == 0) atomicAdd(rowss + row, ss); }
    }
};
struct EpiAct {
    static constexpr bool PERM = true;
    bf16* O; const float* rowss;
    __device__ __forceinline__ void operator()(AccT& acc, const pg8::Unit& u, int wr, int wc, int fr, int fq) const {
        const int row0 = u.pm * 256 + wr * 64 + fr, col0 = u.pn * 256 + wc * 32 + 8 * fq;
#pragma unroll
        for (int ai = 0; ai < 2; ++ai)
#pragma unroll
            for (int m = 0; m < 4; ++m) { const int row = row0 + ai * 128 + m * 16; const float rs = rsqrtf(rowss[row] * (1.f / D) + NORM_EPS); bf16* rowp = O + (size_t)row * DFF + col0;
#pragma unroll
                for (int bj = 0; bj < 2; ++bj) { float o[8];
#pragma unroll
                    for (int e = 0; e < 8; ++e) { const float v = fmaxf(rs * acc[ai][bj][m][e >> 2][e & 3], 0.f); o[e] = v * v; }
                    *(v4u*)(rowp + bj * 128) = pack8(o); } }
    }
};
struct EpiOut {
    static constexpr bool PERM = false;
    float* out; float* rowss;
    __device__ __forceinline__ void operator()(AccT& acc, const pg8::Unit& u, int wr, int wc, int fr, int fq) const {
        const int row0 = u.pm * 256 + wr * 64 + fr, col0 = u.pn * 256 + wc * 32 + 4 * fq;
#pragma unroll
        for (int ai = 0; ai < 2; ++ai)
#pragma unroll
            for (int m = 0; m < 4; ++m) { const int row = row0 + ai * 128 + m * 16; const size_t off = (size_t)row * D + col0; float ss = 0.f;
#pragma unroll
                for (int bj = 0; bj < 2; ++bj)
#pragma unroll
                    for (int n = 0; n < 2; ++n) { const f32x4 h = *(const f32x4*)(out + off + bj * 128 + n * 16) + acc[ai][bj][m][n];
                        *(f32x4*)(out + off + bj * 128 + n * 16) = h; ss += (h[0] * h[0] + h[1] * h[1]) + (h[2] * h[2] + h[3] * h[3]); }
                ss += __shfl_xor(ss, 16); ss += __shfl_xor(ss, 32);
                if (fq == 0) atomicAdd(rowss + row, ss); }
    }
};

#define XB_TMO      128
#define XB_XCNT(j)  (256  + 64 * (j))
#define XB_XSUB(j)  (1280 + 64 * (j))
#define XB_XGEN(j)  (2304 + 64 * (j))
#define XB_TOP      3328
#define XB_TOPGEN   3392
#define XCD_BAR_WORDS 3456
#define XB_SPIN_CAP (1u << 18)
__device__ __forceinline__ unsigned xb_ld(unsigned* p)              { return __hip_atomic_load(p, __ATOMIC_RELAXED, __HIP_MEMORY_SCOPE_AGENT); }
__device__ __forceinline__ unsigned xb_add(unsigned* p, unsigned v) { return __hip_atomic_fetch_add(p, v, __ATOMIC_RELAXED, __HIP_MEMORY_SCOPE_AGENT); }
__device__ __forceinline__ unsigned xb_xcc_id() { return (unsigned)__builtin_amdgcn_s_getreg((3 << 11) | 20) & 0xFu; }
#define XB_SPIN(cond, bar) do { unsigned _sp = 0; while (cond) { __builtin_amdgcn_s_sleep(1); \
    if ((++_sp & 255u) == 0u) { if (xb_ld(&(bar)[XB_TMO])) break; if (_sp > XB_SPIN_CAP) { atomicAdd(&(bar)[XB_TMO], 1u); break; } } } } while (0)
struct XcdBarrier { unsigned* bar; unsigned x; volatile LAS unsigned* st; };
__device__ __forceinline__ XcdBarrier xcd_barrier_post(unsigned* bar, volatile LAS unsigned* st) {
    XcdBarrier b; b.bar = bar; b.x = xb_xcc_id(); b.st = st;
    if (threadIdx.x == 0) (void)xb_add(&bar[XB_XCNT(b.x)], 1u);
    return b;
}
__device__ __forceinline__ void xcd_barrier_complete(unsigned* bar, unsigned x, unsigned& nloc, unsigned& nx) {
    const unsigned G = gridDim.x * gridDim.y * gridDim.z;
    unsigned sum, cnt, mine, sp = 0u;
    for (;;) {
        sum = 0u; cnt = 0u; mine = 0u;
#pragma unroll
        for (unsigned j = 0; j < 16; ++j) { const unsigned c = xb_ld(&bar[XB_XCNT(j)]); sum += c; cnt += (c > 0u) ? 1u : 0u; mine = (j == x) ? c : mine; }
        if (sum == G) break;
        __builtin_amdgcn_s_sleep(1);
        if ((++sp & 255u) == 0u) { if (xb_ld(&bar[XB_TMO])) break; if (sp > XB_SPIN_CAP) { atomicAdd(&bar[XB_TMO], 1u); break; } }
    }
    nloc = mine > 0u ? mine : 1u; nx = cnt > 0u ? cnt : 1u;
}
__device__ __forceinline__ void xcd_barrier(const XcdBarrier& b) {
    asm volatile("s_waitcnt vmcnt(0)" ::: "memory");
    __syncthreads();
    if (threadIdx.x == 0) {
        unsigned* bar = b.bar;
        __builtin_amdgcn_s_waitcnt(0);
        unsigned nloc = b.st[0], nx = b.st[1];
        if (nloc == 0u) { xcd_barrier_complete(bar, b.x, nloc, nx); b.st[0] = nloc; b.st[1] = nx; }
        const unsigned old = xb_add(&bar[XB_XSUB(b.x)], 1u);
        const unsigned gen = old / nloc;
        if (old + 1u == (gen + 1u) * nloc) {
            __builtin_amdgcn_fence(__ATOMIC_RELEASE, "agent");
            asm volatile("s_waitcnt vmcnt(0)" ::: "memory");
            const unsigned og = xb_add(&bar[XB_TOP], 1u);
            const unsigned tg = og / nx;
            if (og + 1u == (tg + 1u) * nx) xb_add(&bar[XB_TOPGEN], 1u);
            else XB_SPIN(xb_ld(&bar[XB_TOPGEN]) == tg, bar);
            __builtin_amdgcn_fence(__ATOMIC_ACQUIRE, "agent");
            xb_add(&bar[XB_XGEN(b.x)], 1u);
            asm volatile("s_waitcnt vmcnt(0)" ::: "memory");
        } else {
            XB_SPIN(xb_ld(&bar[XB_XGEN(b.x)]) == gen, bar);
            __builtin_amdgcn_fence(__ATOMIC_ACQUIRE, "agent");
            asm volatile("s_waitcnt vmcnt(0)" ::: "memory");
        }
    }
    __syncthreads();
}

__device__ __forceinline__ float wave_sum(float v) {
#pragma unroll
    for (int o = 1; o < 64; o <<= 1) v += __shfl_xor(v, o);
    return v;
}
struct TrItem { const float* W; bf16* WT; const float* scale; int ldw, ldt, k0, n0, dr, mode, fbase, fmul; };
__device__ __forceinline__ void p0_issue(const TrItem& t, f32x4 (&v)[8], int ln) {
    const int r = ln >> 3, c4 = ln & 7;
#pragma unroll
    for (int i = 0; i < 8; ++i) v[i] = *(const f32x4*)(t.W + (size_t)(t.k0 + 8 * i + r) * t.ldw + t.n0 + 4 * c4);
}
__device__ __forceinline__ void p0_finish(const TrItem& t, const f32x4 (&v)[8], LAS float* scr, int ln) {
    const int r = ln >> 3, c4 = ln & 7;
#pragma unroll
    for (int i = 0; i < 8; ++i) { const int kk = 8 * i + r; const float sc = t.scale ? t.scale[t.k0 + kk] : 1.f;
#pragma unroll
        for (int j = 0; j < 4; ++j) scr[kk * 33 + 4 * c4 + j] = v[i][j] * sc; }
    LDS_WAIT(); asm volatile("" ::: "memory");
    const int c = ln & 7;
#pragma unroll
    for (int j = 0; j < 4; ++j) { const int n = (ln >> 3) + 8 * j; const LAS float* s = scr + (8 * c) * 33 + n;
        v4u o; o.x = pk2(s[0 * 33], s[1 * 33]); o.y = pk2(s[2 * 33], s[3 * 33]); o.z = pk2(s[4 * 33], s[5 * 33]); o.w = pk2(s[6 * 33], s[7 * 33]);
        const int k = t.k0 + 8 * c;
        if (t.mode == 0) *(v4u*)(t.WT + (size_t)(t.dr + n) * t.ldt + k) = o;
        else { const int ch = t.dr + n, w8 = ch >> 5, i5 = ch & 31, f = t.fbase + (k >> 5) * t.fmul + ((i5 >> 2) & 1), fr = ((i5 >> 3) << 2) | (i5 & 3), fq = (k >> 3) & 3;
            *(v4u*)(t.WT + ((size_t)(w8 * 32 + f) * 64 + fq * 16 + fr) * 8) = o; } }
    LDS_WAIT(); asm volatile("" ::: "memory");
}
__device__ __forceinline__ void rms_row_to_bf16(const float* xrow, const float* g, bf16* orow, int lane) {
    const f32x4* xr = (const f32x4*)xrow + lane; const f32x4* gr = (const f32x4*)g + lane;
    f32x4 v[8]; float s = 0.f;
#pragma unroll
    for (int j = 0; j < 8; ++j) { v[j] = xr[64 * j]; s += (v[j][0] * v[j][0] + v[j][1] * v[j][1]) + (v[j][2] * v[j][2] + v[j][3] * v[j][3]); }
    const float rs = rsqrtf(wave_sum(s) * (1.f / D) + NORM_EPS);
    v2u* o8 = (v2u*)orow + lane;
#pragma unroll
    for (int j = 0; j < 8; ++j) { const f32x4 gg = gr[64 * j]; v2u w; w.x = pk2(v[j][0] * rs * gg[0], v[j][1] * rs * gg[1]); w.y = pk2(v[j][2] * rs * gg[2], v[j][3] * rs * gg[3]); o8[64 * j] = w; }
}
__device__ __forceinline__ void load_row8(const bf16* proj, const float* pmeta, int b, int tpos, int cg, int c0, float (&f)[8]) {
    if (tpos >= 0) unpack8(*(const v4u*)(proj + (size_t)(b * SEQ + tpos) * PST + cg * D + c0), f);
    else { const float* p = pmeta + (size_t)(NMETA + tpos) * (2 * D) + cg * D + c0; const f32x4 a = *(const f32x4*)p, c = *(const f32x4*)(p + 4);
#pragma unroll
        for (int e = 0; e < 4; ++e) { f[e] = a[e]; f[4 + e] = c[e]; } }
}


constexpr int MX_AD = 0, MX_AX = 65536;
__device__ __forceinline__ v4u load_row8p(const bf16* proj, int b, int tpos, int cg, int c0) {
    return *(const v4u*)(proj + (size_t)(b * PROWS + NMETA + tpos) * PST + cg * D + c0);
}
template <int W> __device__ __forceinline__ void build_d(const bf16* proj, LAS unsigned char* lds, int b, int tl0, int g, int t) {
    const int kc = t & 63, rb = t >> 6, c0 = 512 * g + 8 * kc;
    v4u v[W + 7];
#pragma unroll
    for (int i = 0; i < W + 7; ++i) v[i] = load_row8p(proj, b, tl0 + 8 * rb - (W - 1) + i, 0, c0);
    __builtin_amdgcn_sched_barrier(0);
    float s[8], f[8], o[8];
#pragma unroll
    for (int e = 0; e < 8; ++e) s[e] = 0.f;
#pragma unroll
    for (int i = 0; i < W; ++i) { unpack8(v[i], f);
#pragma unroll
        for (int e = 0; e < 8; ++e) s[e] += f[e]; }
#pragma unroll
    for (int r = 0; r < 8; ++r) { unpack8(v[r + W - 1], f);
#pragma unroll
        for (int e = 0; e < 8; ++e) o[e] = s[e] * (1.f / W) - f[e];
        const int row = 8 * rb + r;
        *(LAS v4u*)(lds + MX_AD + row * 1024 + ((kc ^ (row & 15)) << 4)) = pack8(o);
        if (r < 7) { float fo[8]; unpack8(v[r + W], f); unpack8(v[r], fo);
#pragma unroll
            for (int e = 0; e < 8; ++e) s[e] += f[e] - fo[e]; } }
}
__device__ __forceinline__ void build_xc(const bf16* proj, const float* conv_w, const float* conv_b, LAS unsigned char* lds, int b, int tl0, int s, int t) {
    const int kc = t & 31, rb = t >> 5, c0 = 256 * s + 8 * kc;
    v4u v[7];
#pragma unroll
    for (int i = 0; i < 7; ++i) v[i] = load_row8p(proj, b, tl0 + 4 * rb - 3 + i, 1, c0);
    __builtin_amdgcn_sched_barrier(0);
    float o[4][8], f[8];
    { const f32x4 a = *(const f32x4*)(conv_b + c0), c = *(const f32x4*)(conv_b + c0 + 4);
#pragma unroll
      for (int r = 0; r < 4; ++r)
#pragma unroll
          for (int e = 0; e < 4; ++e) { o[r][e] = a[e]; o[r][4 + e] = c[e]; } }
#pragma unroll
    for (int k = 0; k < 4; ++k) { const f32x4 a = *(const f32x4*)(conv_w + k * D + c0), c = *(const f32x4*)(conv_w + k * D + c0 + 4);
#pragma unroll
        for (int r = 0; r < 4; ++r) { unpack8(v[r + k], f);
#pragma unroll
            for (int e = 0; e < 4; ++e) { o[r][e] += a[e] * f[e]; o[r][4 + e] += c[e] * f[4 + e]; } } }
#pragma unroll
    for (int r = 0; r < 4; ++r) { const int row = 4 * rb + r; *(LAS v4u*)(lds + MX_AX + row * 512 + ((kc ^ (row & 15)) << 4)) = pack8(o[r]); }
}
#define MX_BPTR(f) ((f) < 32 ? pB + (f) * 512 : gA + ((f) - 32) * 512)
template <int F0, int F1> __device__ __forceinline__ void mixer_prefetch(bf16x8 (&ring)[16], const bf16* POOL_T, const bf16* GATE_T, int chs, int ln) {
    const bf16* pB = POOL_T + ((size_t)(chs >> 5) * 32 * 64 + ln) * 8; const bf16* gA = GATE_T + ((size_t)(chs >> 5) * 32 * 64 + ln) * 8;
#pragma unroll
    for (int f = F0; f < F1; ++f) ring[f] = *(const bf16x8*)MX_BPTR(f);
}
__device__ __forceinline__ void mixer_wave(bf16x8 (&ring)[16], LAS unsigned char* lds, const bf16* POOL_T, const bf16* GATE_T, const bf16* PROJ, const float* pscale, const float* ba, const float* bx, const float* nls,
                                           bf16* M0, bf16* M1, float* ach, float* bch, int chunk, int chs, int wv, int ln, int probe) {
    const int fr = ln & 15, fq = ln >> 4;
    const bf16* pB = POOL_T + ((size_t)(chs >> 5) * 32 * 64 + ln) * 8; const bf16* gA = GATE_T + ((size_t)(chs >> 5) * 32 * 64 + ln) * 8;
    f32x4 accp[4][2], accr[4][2], acci[4][2];
#pragma unroll
    for (int m = 0; m < 4; ++m)
#pragma unroll
        for (int n = 0; n < 2; ++n) { accp[m][n] = (f32x4){0.f, 0.f, 0.f, 0.f}; accr[m][n] = (f32x4){0.f, 0.f, 0.f, 0.f}; acci[m][n] = (f32x4){0.f, 0.f, 0.f, 0.f}; }
    const LAS unsigned char* ad = lds + MX_AD + fr * 1024;
    const LAS unsigned char* ax = lds + MX_AX + fr * 512;
#define MX_APTR(q, m) ((q) < 16 ? ad + (m) * 16384 + (((4 * (q) + fq) ^ fr) << 4) : ax + (m) * 8192 + (((4 * ((q) - 16) + fq) ^ fr) << 4))
    bf16x8 an[4];
#pragma unroll
    for (int m = 0; m < 4; ++m) an[m] = *(const LAS bf16x8*)MX_APTR(0, m);
#pragma unroll
    for (int ks = 0; ks < 16; ++ks) {
        const bf16x8 b0 = ring[(2 * ks) & 15], b1 = ring[(2 * ks + 1) & 15];
        bf16x8 a[4];
#pragma unroll
        for (int m = 0; m < 4; ++m) a[m] = an[m];
#pragma unroll
        for (int m = 0; m < 4; ++m) an[m] = *(const LAS bf16x8*)MX_APTR(ks + 1, m);
        __builtin_amdgcn_sched_barrier(0);
#pragma unroll
        for (int m = 0; m < 4; ++m) { accp[m][0] = __builtin_amdgcn_mfma_f32_16x16x32_bf16(b0, a[m], accp[m][0], 0, 0, 0); accp[m][1] = __builtin_amdgcn_mfma_f32_16x16x32_bf16(b1, a[m], accp[m][1], 0, 0, 0); }
        ring[(2 * ks) & 15] = *(const bf16x8*)MX_BPTR(2 * ks + 16); ring[(2 * ks + 1) & 15] = *(const bf16x8*)MX_BPTR(2 * ks + 17);
    }
#pragma unroll
    for (int ks = 0; ks < 8; ++ks) {
        const bf16x8 r0 = ring[(4 * ks) & 15], r1 = ring[(4 * ks + 1) & 15], i0 = ring[(4 * ks + 2) & 15], i1 = ring[(4 * ks + 3) & 15];
        bf16x8 a[4];
#pragma unroll
        for (int m = 0; m < 4; ++m) a[m] = an[m];
        if (ks < 7) {
#pragma unroll
            for (int m = 0; m < 4; ++m) an[m] = *(const LAS bf16x8*)MX_APTR(16 + ks + 1, m); }
        __builtin_amdgcn_sched_barrier(0);
#pragma unroll
        for (int m = 0; m < 4; ++m) {
            accr[m][0] = __builtin_amdgcn_mfma_f32_16x16x32_bf16(r0, a[m], accr[m][0], 0, 0, 0); accr[m][1] = __builtin_amdgcn_mfma_f32_16x16x32_bf16(r1, a[m], accr[m][1], 0, 0, 0);
            acci[m][0] = __builtin_amdgcn_mfma_f32_16x16x32_bf16(i0, a[m], acci[m][0], 0, 0, 0); acci[m][1] = __builtin_amdgcn_mfma_f32_16x16x32_bf16(i1, a[m], acci[m][1], 0, 0, 0); }
        if (ks < 4) {
#pragma unroll
            for (int q = 0; q < 4; ++q) ring[(4 * ks + q) & 15] = *(const bf16x8*)MX_BPTR(32 + 4 * ks + q + 16); }
    }
    if (probe) {
#pragma unroll
        for (int m = 0; m < 4; ++m)
#pragma unroll
            for (int n = 0; n < 2; ++n) asm volatile("" :: "v"(accp[m][n]), "v"(accr[m][n]), "v"(acci[m][n]));
        return; }
    const int ch0 = chs + 8 * fq;
    float cba[8], cbx[8], cnl[8];
    { const f32x4 a0 = *(const f32x4*)(ba + ch0), a1 = *(const f32x4*)(ba + ch0 + 4), b0 = *(const f32x4*)(bx + ch0), b1 = *(const f32x4*)(bx + ch0 + 4), c0 = *(const f32x4*)(nls + ch0), c1 = *(const f32x4*)(nls + ch0 + 4);
#pragma unroll
      for (int e = 0; e < 4; ++e) { cba[e] = a0[e]; cba[4 + e] = a1[e]; cbx[e] = b0[e]; cbx[4 + e] = b1[e]; cnl[e] = c0[e]; cnl[4 + e] = c1[e]; } }
#pragma unroll
    for (int m = 0; m < 4; ++m) { float xc[8]; unpack8(*(const LAS v4u*)(ax + m * 8192 + (((4 * wv + fq) ^ fr) << 4)), xc);
#pragma unroll
        for (int e = 0; e < 8; ++e) { const float r = sigm(accr[m][e >> 2][e & 3] + cba[e]), ig = sigm(acci[m][e >> 2][e & 3] + cbx[e]);
            const float t = expm1_neg(cnl[e] * r);
            accr[m][e >> 2][e & 3] = 1.f + t; acci[m][e >> 2][e & 3] = __builtin_amdgcn_sqrtf(-t * (2.f + t)) * ig * xc[e]; } }
#pragma unroll
    for (int m = 0; m < 4; ++m)
#pragma unroll
        for (int e = 0; e < 8; ++e) { float A = accr[m][e >> 2][e & 3], B = acci[m][e >> 2][e & 3], As, Bs;
            As = dpp_shr<1>(1.f, A); Bs = dpp_shr<1>(0.f, B); B = A * Bs + B; A = A * As;
            As = dpp_shr<2>(1.f, A); Bs = dpp_shr<2>(0.f, B); B = A * Bs + B; A = A * As;
            As = dpp_shr<4>(1.f, A); Bs = dpp_shr<4>(0.f, B); B = A * Bs + B; A = A * As;
            As = dpp_shr<8>(1.f, A); Bs = dpp_shr<8>(0.f, B); B = A * Bs + B; A = A * As;
            accr[m][e >> 2][e & 3] = A; acci[m][e >> 2][e & 3] = B; }
    const int lane15 = ln | 15;
#pragma unroll
    for (int m = 1; m < 4; ++m)
#pragma unroll
        for (int e = 0; e < 8; ++e) { const float CA = __shfl(accr[m - 1][e >> 2][e & 3], lane15), CB = __shfl(acci[m - 1][e >> 2][e & 3], lane15);
            const float A = accr[m][e >> 2][e & 3], B = acci[m][e >> 2][e & 3];
            acci[m][e >> 2][e & 3] = A * CB + B; accr[m][e >> 2][e & 3] = A * CA; }
    float ps[8];
    { const f32x4 a = *(const f32x4*)(pscale + ch0), c = *(const f32x4*)(pscale + ch0 + 4);
#pragma unroll
      for (int e = 0; e < 4; ++e) { ps[e] = a[e]; ps[4 + e] = c[e]; } }
#pragma unroll
    for (int m = 0; m < 4; ++m) { const size_t row = (size_t)chunk * 64 + 16 * m + fr; const bf16* rowp = PROJ + prow((int)row) * PST + ch0; float gg[8], sg[8], o0[8], o1[8];
        unpack8(*(const v4u*)(rowp + COL_G), gg); unpack8(*(const v4u*)(rowp + COL_SGP), sg);
#pragma unroll
        for (int e = 0; e < 8; ++e) { o0[e] = sg[e] * ps[e] * accp[m][e >> 2][e & 3] + gg[e] * acci[m][e >> 2][e & 3]; o1[e] = gg[e] * accr[m][e >> 2][e & 3]; }
        *(v4u*)(M0 + row * D + ch0) = pack8(o0); *(v4u*)(M1 + row * D + ch0) = pack8(o1); }
    if (fr == 15) { float* pa = ach + (size_t)chunk * D + ch0; float* pb = bch + (size_t)chunk * D + ch0;
        *(f32x4*)pa = accr[3][0]; *(f32x4*)(pa + 4) = accr[3][1]; *(f32x4*)pb = acci[3][0]; *(f32x4*)(pb + 4) = acci[3][1]; }
}

struct Args { const float* in[18]; float* out; unsigned char* ws; int ph_lo, ph_hi, li, pad; };
__global__ void __launch_bounds__(NWAVES * 64, 2) fwd_kernel(Args args) {
    extern __shared__ __attribute__((aligned(16))) unsigned char lds_raw[];
    LAS unsigned char* lds = (LAS unsigned char*)lds_raw;
    volatile LAS unsigned* MISC = (volatile LAS unsigned*)(lds + MISC_OFF);
#define tid (pg8::tid_opaque())
#define lane (pg8::tid_opaque() & 63)
#define wave (__builtin_amdgcn_readfirstlane(pg8::tid_opaque() >> 6))
    const int G = gridDim.x; const int bx = blockIdx.x; const int vcu = (G % 8 == 0) ? (bx % 8) * (G / 8) + bx / 8 : bx;
    unsigned char* ws = args.ws;
    gu32* ctl = (gu32*)(ws + WS_CTL);
    const float* x = args.in[0]; const float* meta = args.in[1]; const float* norm1_g = args.in[2]; const float* w_in = args.in[3];
    const float* pool_w = args.in[4]; const float* pool_scale = args.in[5]; const float* conv_w = args.in[6]; const float* conv_b = args.in[7];
    const float* gate_a_w = args.in[8]; const float* gate_a_b = args.in[9]; const float* gate_x_w = args.in[10]; const float* gate_x_b = args.in[11];
    const float* lru_lambda = args.in[12]; const float* w_out = args.in[13]; const float* norm2_g = args.in[14]; const float* mlp_w1 = args.in[15];
    const float* mlp_w2 = args.in[16]; const float* final_g = args.in[17];
    float* out = args.out;
    bf16* WIN_T = (bf16*)(ws + WS_WIN_T); bf16* WOUT_T = (bf16*)(ws + WS_WOUT_T); bf16* W1_T = (bf16*)(ws + WS_W1_T); bf16* W2_T = (bf16*)(ws + WS_W2_T);
    bf16* POOL_T = (bf16*)(ws + WS_POOL_T); bf16* GATE_T = (bf16*)(ws + WS_GATE_T);
    bf16* PROJ = (bf16*)(ws + WS_PROJ); bf16* ACT = (bf16*)(ws + WS_ACT); bf16* U = (bf16*)(ws + WS_U); bf16* MBUF0 = U;
    bf16* MBUF1 = (bf16*)(ws + WS_XCB); bf16* H1BF = (bf16*)(ws + WS_H1BF); bf16* UMETA = (bf16*)(ws + WS_UMETA);
    float* PROJMETA = (float*)(ws + WS_PROJMETA); float* HMETA = (float*)(ws + WS_HMETA); float* NLS = (float*)(ws + WS_NLS);
    float* ACH = (float*)(ws + WS_ACH); float* BCH = (float*)(ws + WS_BCH); float* CARRY = (float*)(ws + WS_CARRY);
    float* ROWSS1 = (float*)(ws + WS_ROWSS1); float* ROWSS2 = (float*)(ws + WS_ROWSS2);

    for (int u = tid; u < (LDS_BYTES - LDSCTL_OFF) / 4; u += NWAVES * 64) ((LAS unsigned*)(lds + LDSCTL_OFF))[u] = 0u;
    __syncthreads();
    XcdBarrier bar; bar.bar = (unsigned*)(ctl + CW_BAR); bar.x = 0; bar.st = nullptr;
    if (N_LAUNCHES == 1) bar = xcd_barrier_post((unsigned*)(ctl + CW_BAR), MISC + 8);
#ifndef MK_TS
#define MK_TS -1
#endif
#define STAMP(k) do { if (MK_TS >= 0 && bx == 0 && tid == 0) { const unsigned long long t_ = __builtin_amdgcn_s_memrealtime(); MISC[16 + 2 * (k)] = (unsigned)t_; MISC[17 + 2 * (k)] = (unsigned)(t_ >> 32); } } while (0)
#define GRID_BAR() do { if (N_LAUNCHES == 1) xcd_barrier(bar); } while (0)
    const int lo = args.ph_lo, hi = args.ph_hi;
#ifndef MK_PHASE_MASK
#define MK_PHASE_MASK 0x1ff
#endif
#ifndef MK_REP_MASK
#define MK_REP_MASK 0
#endif
#define REP(k) for (int rep_ = 0; rep_ < 1 + ((MK_REP_MASK >> (k)) & 1); ++rep_)
#define IN(k) (((MK_PHASE_MASK >> (k)) & 1) && lo <= (k) && (k) < hi)
#define BOTH(k) (IN(k) && IN((k) + 1))
#if MK_SIMPLE_GEMM
#define RUN_GEMM(EpiT, g, S, E) pg8::gemm_simple<EpiT, pg8::StaticOrder>(g, S, E)
#else
#define RUN_GEMM(EpiT, g, S, E) pg8::gemm_phase<EpiT, pg8::StaticOrder, true, true>(lds + RING_OFF, g, S, E)
#endif

    STAMP(0);
    if (IN(0)) { REP(0) {
        LAS float* scr = (LAS float*)(lds + RING_OFF + wave * 16384);
        const int gw = vcu * NWAVES + wave, NGW = G * NWAVES;
        constexpr int I_IN = 32 * 320, I_OUT = 32 * 64, I_1 = 32 * 256, I_2 = 128 * 64, I_P = 4 * 8 * 16, I_G = 2 * 8 * 4 * 8;
        constexpr int NITEMS = I_IN + I_OUT + I_1 + I_2 + I_P + I_G;
        auto decode = [&](int it, TrItem& t) -> bool {
            if (it >= NITEMS) return false;
            int r = it; t.scale = nullptr; t.mode = 0; t.fbase = 0; t.fmul = 0;
            if (r < I_IN) { const int kb = r / 320, nb = r % 320, n0 = 32 * nb; int dr = n0;
                if (n0 >= 4 * D) { const int ch = n0 - 4 * D; dr = 256 * (16 + (ch >> 7)) + 128 + (ch & 127); }
                else if (n0 >= 3 * D) dr = 4 * D + (n0 - 3 * D);
                else if (n0 >= 2 * D) { const int ch = n0 - 2 * D; dr = 256 * (16 + (ch >> 7)) + (ch & 127); }
                t.W = w_in; t.ldw = INC; t.k0 = 64 * kb; t.n0 = n0; t.WT = WIN_T; t.ldt = D; t.dr = dr; return true; } r -= I_IN;
            if (r < I_OUT) { const int kb = r / 64, nb = r % 64; t.W = w_out; t.ldw = D; t.k0 = 64 * kb; t.n0 = 32 * nb; t.WT = WOUT_T; t.ldt = D; t.dr = 32 * nb; return true; } r -= I_OUT;
            if (r < I_1) { const int kb = r / 256, nb = r % 256; t.W = mlp_w1; t.ldw = DFF; t.k0 = 64 * kb; t.n0 = 32 * nb; t.WT = W1_T; t.ldt = D; t.dr = 32 * nb; t.scale = norm2_g; return true; } r -= I_1;
            if (r < I_2) { const int kb = r / 64, nb = r % 64; t.W = mlp_w2; t.ldw = D; t.k0 = 64 * kb; t.n0 = 32 * nb; t.WT = W2_T; t.ldt = DFF; t.dr = 32 * nb; return true; } r -= I_2;
            if (r < I_P) { const int g = r / 128, q = r % 128, kb = q / 16, nb = q % 16; t.W = pool_w + (size_t)g * 512 * 512; t.ldw = 512; t.k0 = 64 * kb; t.n0 = 32 * nb; t.WT = POOL_T; t.ldt = 512; t.dr = 512 * g + 32 * nb;
                t.mode = 1; t.fbase = 0; t.fmul = 2; return true; } r -= I_P;
            { const int gate = r / 256, q = r % 256, h = q / 32, q2 = q % 32, kb = q2 / 8, nb = q2 % 8, j0 = 32 * nb;
              t.W = (gate ? gate_x_w : gate_a_w) + (size_t)h * 65536; t.ldw = 256; t.k0 = 64 * kb; t.n0 = j0; t.WT = GATE_T; t.ldt = 256; t.dr = 256 * h + j0; t.mode = 1; t.fbase = 2 * gate; t.fmul = 4; return true; }
        };
        { TrItem tc, tn; f32x4 vc[8], vn[8]; int it = gw;
          if (decode(it, tc)) { p0_issue(tc, vc, lane);
              for (;;) { it += NGW; const bool has = decode(it, tn);
                  if (has) p0_issue(tn, vn, lane);
                  p0_finish(tc, vc, scr, lane);
                  if (!has) break;
                  tc = tn;
#pragma unroll
                  for (int i = 0; i < 8; ++i) vc[i] = vn[i]; } } }
        for (int m = gw; m < MR + NMETA; m += NGW) {
            if (m < MR) rms_row_to_bf16(x + (size_t)m * D, norm1_g, U + (size_t)m * D, lane);
            else rms_row_to_bf16(meta + (size_t)(m - MR) * D, norm1_g, UMETA + (size_t)(m - MR) * D, lane);
        }
        if (bx == 0) for (int c = tid; c < D; c += NWAVES * 64) NLS[c] = -8.f * log1pf(expf(-lru_lambda[c]));
        }
        if (BOTH(0)) GRID_BAR();
        STAMP(1);
    }

    if (IN(1)) {
        REP(1) { pg8::Gemm g{U, WIN_T, D, D, 1 << 30}; pg8::StaticOrder S; S.init(MR, INC, G, bx); EpiProj E{PROJ};
          RUN_GEMM(EpiProj, g, S, E); }
        __syncthreads();
        for (int nb = bx; nb < 256; nb += G) {
            const int fr = lane & 15, fq = lane >> 4, n0 = 16 * nb;
            f32x4 acc = (f32x4){0.f, 0.f, 0.f, 0.f};
#pragma unroll
            for (int kk = 0; kk < 8; ++kk) { const int k = 256 * wave + 32 * kk + 8 * fq;
                const bf16x8 a = *(const bf16x8*)(UMETA + (size_t)fr * D + k), b = *(const bf16x8*)(WIN_T + (size_t)(n0 + fr) * D + k);
                acc = __builtin_amdgcn_mfma_f32_16x16x32_bf16(a, b, acc, 0, 0, 0); }
            LAS f32x4* red = (LAS f32x4*)(lds + RING_OFF);
            red[wave * 64 + lane] = acc;
            __syncthreads();
            if (wave == 0) { f32x4 s = red[lane];
#pragma unroll
                for (int w = 1; w < 8; ++w) s += red[w * 64 + lane];
#pragma unroll
                for (int r = 0; r < 4; ++r) { PROJMETA[(size_t)(4 * fq + r) * (2 * D) + n0 + fr] = s[r]; const bf16 hb = (bf16)f2bf(s[r]);
                    PROJ[(size_t)(4 * fq + r) * PST + n0 + fr] = hb; PROJ[(size_t)(PROWS + 4 * fq + r) * PST + n0 + fr] = hb; } }
            __syncthreads();
        }
        if (BOTH(1)) GRID_BAR();
        STAMP(2);
    }

    if (IN(2)) {
#ifndef MK_PROBE
#define MK_PROBE 0
#endif
        for (int pass_ = (MK_PROBE ? 0 : 1); pass_ < 2; ++pass_) for (int t = bx; t < NCHUNK * 8; t += G) {
            int probe = (pass_ == 0); asm volatile("" : "+s"(probe));
            const int s = t & 7, chunk = t >> 3, g = s >> 1, b = chunk >> 6, tl0 = (chunk & 63) * 64;
            bf16x8 ring[16];
            if (!(probe && MK_PROBE == 3)) mixer_prefetch<0, 8>(ring, POOL_T, GATE_T, 256 * s + 32 * wave, lane);
            if (!(probe && MK_PROBE == 2)) { const int tt = tid;
              if (g == 0) build_d<2>(PROJ, lds, b, tl0, g, tt); else if (g == 1) build_d<4>(PROJ, lds, b, tl0, g, tt);
              else if (g == 2) build_d<8>(PROJ, lds, b, tl0, g, tt); else build_d<16>(PROJ, lds, b, tl0, g, tt);
              build_xc(PROJ, conv_w, conv_b, lds, b, tl0, s, tt); }
            if (!(probe && MK_PROBE == 3)) mixer_prefetch<8, 16>(ring, POOL_T, GATE_T, 256 * s + 32 * wave, lane);
            __syncthreads();
            if (!(probe && MK_PROBE == 3)) { const int wv = wave; mixer_wave(ring, lds, POOL_T, GATE_T, PROJ, pool_scale, gate_a_b, gate_x_b, NLS, MBUF0, MBUF1, ACH, BCH, chunk, 256 * s + 32 * wv, wv, lane, probe); }
            __syncthreads();
        }
        if (BOTH(2)) GRID_BAR();
        STAMP(3);
    }

    if (IN(3)) {
        for (int cb = bx; cb < D / 8; cb += G) {
            const int h = cb >> 5, j0 = (8 * cb) & 255;
            LAS float* xs = (LAS float*)(lds + RING_OFF);
            LAS float* rg = (LAS float*)(lds + RING_OFF + 16384);
            for (int i = tid; i < 16 * 256; i += NWAVES * 64) { const int p = i >> 8, c = 256 * h + (i & 255); float sx = conv_b[c];
                for (int k = 0; k < 4; ++k) { const int q = p - 3 + k; if (q >= 0) sx += conv_w[k * D + c] * PROJMETA[(size_t)q * (2 * D) + D + c]; }
                xs[i] = sx; }
            __syncthreads();
            { const int t = tid, q = t >> 5, sl = t & 31, gate = q >> 3, jj = q & 7;
              const float* W = (gate ? gate_x_w : gate_a_w) + (size_t)h * 65536 + j0 + jj;
              float part[16];
#pragma unroll
              for (int p = 0; p < 16; ++p) part[p] = 0.f;
#pragma unroll
              for (int ii = 0; ii < 8; ++ii) { const int i = 8 * sl + ii; const float wv = W[i * 256];
#pragma unroll
                  for (int p = 0; p < 16; ++p) part[p] += xs[p * 256 + i] * wv; }
#pragma unroll
              for (int o = 1; o < 32; o <<= 1)
#pragma unroll
                  for (int p = 0; p < 16; ++p) part[p] += __shfl_xor(part[p], o);
              if (sl == 0) { const float bias = (gate ? gate_x_b : gate_a_b)[256 * h + j0 + jj];
#pragma unroll
                  for (int p = 0; p < 16; ++p) rg[q * 16 + p] = sigm(part[p] + bias); } }
            __syncthreads();
            if (tid < 16) { const int t = tid, jj = t & 7, b = t >> 3, ch = 8 * cb + jj; const float nl = NLS[ch]; float hh = 0.f;
                for (int p = 0; p < 16; ++p) { const float r = rg[jj * 16 + p], ig = rg[(8 + jj) * 16 + p], la = nl * r, a = expf(la), mult = sqrtf(-expm1f(2.f * la));
                    hh = a * hh + mult * ig * xs[p * 256 + j0 + jj]; }
                float carry = hh;
                for (int k0 = 0; k0 < 64; k0 += 16) { float av[16], bv[16];
#pragma unroll
                    for (int k = 0; k < 16; ++k) { const size_t o = (size_t)(b * 64 + k0 + k) * D + ch; av[k] = ACH[o]; bv[k] = BCH[o]; }
#pragma unroll
                    for (int k = 0; k < 16; ++k) { CARRY[(size_t)(b * 64 + k0 + k) * D + ch] = carry; carry = av[k] * carry + bv[k]; } } }
            __syncthreads();
        }
        if (BOTH(3)) GRID_BAR();
        STAMP(4);
    }

    if (IN(4)) {
        const int gw = vcu * NWAVES + wave, NGW = G * NWAVES, ln = lane;
        for (int m0 = 4 * gw; m0 < MR; m0 += 4 * NGW) {
#pragma unroll
            for (int r = 0; r < 4; ++r) { const int m = m0 + r; const float* cr = CARRY + (size_t)(m >> 6) * D;
#pragma unroll
                for (int q = 0; q < 4; ++q) { const int c = 512 * q + 8 * ln; float a0[8], a1[8], o[8];
                    unpack8(*(const v4u*)(MBUF0 + (size_t)m * D + c), a0); unpack8(*(const v4u*)(MBUF1 + (size_t)m * D + c), a1);
                    const f32x4 c0 = *(const f32x4*)(cr + c), c1 = *(const f32x4*)(cr + c + 4);
#pragma unroll
                    for (int e = 0; e < 8; ++e) o[e] = a0[e] + a1[e] * (e < 4 ? c0[e & 3] : c1[e & 3]);
                    *(v4u*)(MBUF0 + (size_t)m * D + c) = pack8(o); } } }
        if (BOTH(4)) GRID_BAR();
        STAMP(5);
    }

    if (IN(5)) {
        { pg8::Gemm g{MBUF0, WOUT_T, D, D, 1 << 30}; pg8::StaticOrder S; S.init(MR, D, G, bx); EpiH1 E{x, out, H1BF, ROWSS1};
          RUN_GEMM(EpiH1, g, S, E); }
        if (BOTH(5)) GRID_BAR();
        STAMP(6);
    }
    if (IN(6)) {
        REP(6) { pg8::Gemm g{H1BF, W1_T, D, D, 1 << 30}; pg8::StaticOrder S; S.init(MR, DFF, G, bx); EpiAct E{ACT, ROWSS1};
          RUN_GEMM(EpiAct, g, S, E); }
        if (BOTH(6)) GRID_BAR();
        STAMP(7);
    }
    if (IN(7)) {
        { pg8::Gemm g{ACT, W2_T, DFF, DFF, 1 << 30}; pg8::StaticOrder S; S.init(MR, D, G, bx); EpiOut E{out, ROWSS2};
          RUN_GEMM(EpiOut, g, S, E); }
        if (BOTH(7)) GRID_BAR();
        STAMP(8);
    }
    if (IN(8)) {
        const int gw = vcu * NWAVES + wave, NGW = G * NWAVES;
        for (int m = gw; m < MR; m += NGW) { const float rs = rsqrtf(ROWSS2[m] * (1.f / D) + NORM_EPS); f32x4* orow = (f32x4*)(out + (size_t)m * D) + lane; const f32x4* gr = (const f32x4*)final_g + lane;
#pragma unroll
            for (int j = 0; j < 8; ++j) { f32x4 v = orow[64 * j]; const f32x4 gg = gr[64 * j]; v = v * rs * gg; orow[64 * j] = v; } }
    }
    if (MK_TS >= 0 && bx == 0 && tid == 0) { STAMP(9);
        const unsigned long long t0 = ((unsigned long long)MISC[17 + 2 * MK_TS] << 32) | MISC[16 + 2 * MK_TS], t1 = ((unsigned long long)MISC[17 + 2 * (MK_TS + 1)] << 32) | MISC[16 + 2 * (MK_TS + 1)];
        const unsigned long long te = __builtin_amdgcn_s_memrealtime(), wait = 4ull * (t1 - t0);
        while (__builtin_amdgcn_s_memrealtime() - te < wait && wait < 400000ull) __builtin_amdgcn_s_sleep(8); }
#undef IN
#undef BOTH
#undef tid
#undef lane
#undef wave
}

extern "C" void kernel_launch(void* const* d_in, const int* in_sizes, int n_in, void* d_out, int out_size, void* d_ws, size_t ws_size, hipStream_t stream) {
    static int grid = 0;
    if (grid == 0) {
        if (n_in != 18 || in_sizes[0] != MR * D || out_size != MR * D || ws_size < WS_END) { fprintf(stderr, "kernel_launch: unexpected shapes or workspace (n_in %d, ws %zu)\n", n_in, ws_size); grid = -1; return; }
        int dev = 0, cus = 0;
        if (hipGetDevice(&dev) != hipSuccess || hipDeviceGetAttribute(&cus, hipDeviceAttributeMultiprocessorCount, dev) != hipSuccess) { grid = -1; return; }
        if (hipFuncSetAttribute((const void*)fwd_kernel, hipFuncAttributeMaxDynamicSharedMemorySize, LDS_BYTES) != hipSuccess) { grid = -1; return; }
        (void)hipGetLastError();
        grid = cus;
    }
    if (grid < 0) return;
    (void)hipMemsetAsync((char*)d_ws + WS_CTL, 0, CTL_ZERO_BYTES, stream);
    Args a{};
    for (int i = 0; i < 18; ++i) a.in[i] = (const float*)d_in[i];
    a.out = (float*)d_out; a.ws = (unsigned char*)d_ws;
    if (N_LAUNCHES == 1) { a.ph_lo = 0; a.ph_hi = NPHASES; a.li = 0; hipLaunchKernelGGL(fwd_kernel, dim3(grid), dim3(NWAVES * 64), LDS_BYTES, stream, a); }
    else for (int li = 0; li < NPHASES; ++li) { a.ph_lo = li; a.ph_hi = li + 1; a.li = li; hipLaunchKernelGGL(fwd_kernel, dim3(grid), dim3(NWAVES * 64), LDS_BYTES, stream, a); }
}
```

```cpp
#include <hip/hip_runtime.h>
#include <cstdio>
#include <cstdint>

#ifndef MK_N_LAUNCHES
#define MK_N_LAUNCHES 1
#endif
#ifndef MK_SIMPLE_GEMM
#define MK_SIMPLE_GEMM 0
#endif

namespace pg8 {
#define PG8_LAS __attribute__((address_space(3)))
typedef unsigned short bf16_t;
typedef short bf16x8 __attribute__((ext_vector_type(8)));
typedef float f32x4 __attribute__((ext_vector_type(4)));
typedef unsigned u32x4 __attribute__((ext_vector_type(4)));
typedef unsigned u32x2 __attribute__((ext_vector_type(2)));
constexpr int BM = 256, BK = 64, HALF = 128, HTB = HALF * BK * 2  , STAGE_BYTES = 8 * HTB, NXCD = 8, WGM = 8;

__host__ __device__ __forceinline__ int lds_byte(int r, int c) { const int st = (r >> 4) * 2 + (c >> 5), rr = r & 15, cc = c & 31, ob = rr * 64 + cc * 2; return st * 1024 + (ob ^ (((ob >> 9) & 1) << 5)); }
__host__ __device__ __forceinline__ void stage_rc(int b, int& R, int& C) { const int st = b / 1024, sb = b % 1024, swz = sb ^ (((sb >> 9) & 1) << 5); R = (st >> 1) * 16 + swz / 64; C = (st & 1) * 32 + (swz % 64) / 2; }
__host__ __device__ __forceinline__ int perm32(int rho) { const int n = rho >> 4, i = rho & 15; return 8 * (i >> 2) + 4 * n + (i & 3); }

__device__ __forceinline__ int tid_opaque() { int t = (int)threadIdx.x; asm volatile("" : "+v"(t)); return t; }
struct Unit { int pm, pn; };
struct Gemm { const bf16_t* A; const bf16_t* Bt; int lda, K, tpg; };

struct StaticOrder {
    int nM, nN, nwg, G, c;
    __host__ __device__ void init(int M, int N, int G_, int c_) { nM = M / BM; nN = N / BM; nwg = nM * nN; G = G_; c = c_; }
    __host__ __device__ bool next(int i, Unit& u) const {
        const long L = (long)i * G + c; if (L >= nwg) return false;
        int wgid = (int)L; { const int q = nwg / NXCD, r = nwg % NXCD, xcd = wgid % NXCD, off = wgid / NXCD; wgid = (xcd < r ? xcd * (q + 1) : r * (q + 1) + (xcd - r) * q) + off; }
        const int nig = WGM * nN, gid = wgid / nig, fm = gid * WGM, gsz = (nM - fm) < WGM ? (nM - fm) : WGM;
        u.pm = fm + ((wgid % nig) % gsz); u.pn = (wgid % nig) / gsz; return true;
    }
    __device__ __forceinline__ void a_ready(const Unit&) const {}
    __device__ __forceinline__ void done(const Unit&) const {}
};

__device__ __forceinline__ unsigned cvt_pk_bf16(float lo, float hi) { unsigned r; asm volatile("v_cvt_pk_bf16_f32 %0, %1, %2" : "=v"(r) : "v"(lo), "v"(hi)); return r; }

template <class Epi, class Sched, bool ALIGN_EPI = false, bool SP2 = false>
__device__ __forceinline__ void gemm_phase(PG8_LAS unsigned char* lds, const Gemm g, const Sched& S, const Epi& E) {
    const int tid = tid_opaque(), wid = __builtin_amdgcn_readfirstlane(tid >> 6), lane = tid & 63, wr = wid >> 2, wc = wid & 3, fr = lane & 15, fq = lane >> 4;
    const int K = g.K, nt = K / BK, lda = g.lda;
    unsigned voffA[2], voffB[2];
#pragma unroll
    for (int i = 0; i < 2; ++i) { int R, C; stage_rc(tid * 16 + i * 8192, R, C); const int Rb = Epi::PERM ? ((R & ~31) + perm32(R & 31)) : R;
        voffA[i] = (unsigned)(R * lda + C) * 2u; voffB[i] = (unsigned)(Rb * K + C) * 2u; }
    const size_t kstep = (size_t)(BK * 2);
    const size_t hstepA = (size_t)HALF * lda * 2, hstepB = (size_t)HALF * K * 2;
    const size_t tstepA = 2 * hstepA, tstepB = 2 * hstepB;
    const unsigned ldsw = (unsigned)wid * 1024u;
    const int aoff = lds_byte(wr * 64 + fr, fq * 8), boff = lds_byte(wc * 32 + fr, fq * 8);
#define PG8_SA(b, h) (((b) * 2 + (h)) * HTB)
#define PG8_SB(b, h) ((4 + (b) * 2 + (h)) * HTB)
#define PG8_STAGE(bufoff, gbase, voff) do { _Pragma("unroll") for (int _i = 0; _i < 2; ++_i) \
        __builtin_amdgcn_global_load_lds((const unsigned*)((const char*)(gbase) + (voff)[_i]), (PG8_LAS unsigned*)(lds + (bufoff) + ldsw + _i * 8192), 16, 0, 0); } while (0)
#define PG8_LDA(dst, b, h) do { _Pragma("unroll") for (int m = 0; m < 4; ++m) _Pragma("unroll") for (int k = 0; k < 2; ++k) dst[m][k] = *(const PG8_LAS bf16x8*)(lds + PG8_SA(b, h) + aoff + m * 2048 + k * 1024); } while (0)
#define PG8_LDB(dst, b, h) do { _Pragma("unroll") for (int n = 0; n < 2; ++n) _Pragma("unroll") for (int k = 0; k < 2; ++k) dst[n][k] = *(const PG8_LAS bf16x8*)(lds + PG8_SB(b, h) + boff + n * 2048 + k * 1024); } while (0)
#define PG8_MMA(ai, bj, At, Bt) do { __builtin_amdgcn_s_setprio(1); _Pragma("unroll") for (int m = 0; m < 4; ++m) _Pragma("unroll") for (int n = 0; n < 2; ++n) _Pragma("unroll") for (int k = 0; k < 2; ++k) \
        acc[ai][bj][m][n] = __builtin_amdgcn_mfma_f32_16x16x32_bf16(Bt[n][k], At[m][k], acc[ai][bj][m][n], 0, 0, 0); __builtin_amdgcn_s_setprio(0); } while (0)
#define PG8_WAIT_V(n) asm volatile("s_waitcnt vmcnt(" #n ")" ::: "memory")
#define PG8_WAIT_L(n) asm volatile("s_waitcnt lgkmcnt(" #n ")" ::: "memory")
#define PG8_BAR __builtin_amdgcn_s_barrier()
#define PG8_SCHED __builtin_amdgcn_sched_barrier(0)
    Unit cur, nxt; int ui = 0;
    if (!S.next(0, cur)) return;
    f32x4 acc[2][2][4][2];
#pragma unroll
    for (int a = 0; a < 2; ++a)
#pragma unroll
        for (int b = 0; b < 2; ++b)
#pragma unroll
            for (int m = 0; m < 4; ++m)
#pragma unroll
                for (int n = 0; n < 2; ++n) acc[a][b][m][n] = (f32x4){0.f, 0.f, 0.f, 0.f};
    bf16x8 At[4][2], B0[2][2], B1[2][2];
    const char* cA = (const char*)g.A + (size_t)cur.pm * tstepA + (size_t)(cur.pn / g.tpg) * K * 2; const char* cB = (const char*)g.Bt + (size_t)cur.pn * tstepB;
    S.a_ready(cur);
    if constexpr (SP2) {
        PG8_STAGE(PG8_SB(0, 0), cB, voffB); PG8_STAGE(PG8_SB(0, 1), cB + hstepB, voffB); PG8_STAGE(PG8_SA(0, 0), cA, voffA); PG8_STAGE(PG8_SA(0, 1), cA + hstepA, voffA);
        if (wr == 1) PG8_BAR;
        PG8_WAIT_V(2); PG8_BAR;
        PG8_STAGE(PG8_SB(1, 0), cB + kstep, voffB); PG8_STAGE(PG8_SA(1, 0), cA + kstep, voffA); PG8_STAGE(PG8_SB(1, 1), cB + hstepB + kstep, voffB);
        PG8_WAIT_V(6); PG8_BAR;
    } else {
        PG8_STAGE(PG8_SB(0, 0), cB, voffB); PG8_STAGE(PG8_SA(0, 0), cA, voffA); PG8_STAGE(PG8_SB(0, 1), cB + hstepB, voffB); PG8_STAGE(PG8_SA(0, 1), cA + hstepA, voffA);
        if (wr == 1) PG8_BAR;
        PG8_WAIT_V(4); PG8_BAR;
        PG8_STAGE(PG8_SB(1, 0), cB + kstep, voffB); PG8_STAGE(PG8_SA(1, 0), cA + kstep, voffA); PG8_STAGE(PG8_SB(1, 1), cB + hstepB + kstep, voffB);
        PG8_WAIT_V(6); PG8_BAR;
    }
    for (;;) {
        const bool has_next = S.next(ui + 1, nxt);
        const char* nA = has_next ? (const char*)g.A + (size_t)nxt.pm * tstepA + (size_t)(nxt.pn / g.tpg) * K * 2 : cA; const char* nB = has_next ? (const char*)g.Bt + (size_t)nxt.pn * tstepB : cB;
        for (int t = 0; t < nt; t += 2) {
            const bool last = (t == nt - 2);
            const char* a1 = cA + (size_t)(t + 1) * kstep;
            const char* a2 = last ? nA : cA + (size_t)(t + 2) * kstep; const char* b2 = last ? nB : cB + (size_t)(t + 2) * kstep;
            const char* a3 = a2 + kstep; const char* b3 = b2 + kstep;
            if (last && has_next) S.a_ready(nxt);
            if constexpr (SP2) {
            PG8_LDB(B0, 0, 0); PG8_LDB(B1, 0, 1); PG8_SCHED; PG8_LDA(At, 0, 0); PG8_STAGE(PG8_SA(1, 1), a1 + hstepA, voffA);
            PG8_WAIT_V(8); PG8_WAIT_L(0); PG8_BAR; PG8_MMA(0, 0, At, B0); PG8_MMA(0, 1, At, B1); PG8_BAR; PG8_SCHED;
            PG8_LDA(At, 0, 1); PG8_STAGE(PG8_SB(0, 0), b2, voffB); PG8_STAGE(PG8_SB(0, 1), b2 + hstepB, voffB); PG8_STAGE(PG8_SA(0, 0), a2, voffA);
            PG8_WAIT_V(8); PG8_WAIT_L(0); PG8_BAR; PG8_MMA(1, 0, At, B0); PG8_MMA(1, 1, At, B1); PG8_BAR; PG8_SCHED;
            PG8_LDB(B0, 1, 0); PG8_LDB(B1, 1, 1); PG8_SCHED; PG8_LDA(At, 1, 0); PG8_STAGE(PG8_SA(0, 1), a2 + hstepA, voffA);
            PG8_WAIT_V(8); PG8_WAIT_L(0); PG8_BAR; PG8_MMA(0, 0, At, B0); PG8_MMA(0, 1, At, B1); PG8_BAR; PG8_SCHED;
            PG8_LDA(At, 1, 1); PG8_STAGE(PG8_SB(1, 0), b3, voffB); PG8_STAGE(PG8_SB(1, 1), b3 + hstepB, voffB); PG8_STAGE(PG8_SA(1, 0), a3, voffA);
            PG8_WAIT_V(8); PG8_WAIT_L(0); PG8_BAR; PG8_MMA(1, 0, At, B0); PG8_MMA(1, 1, At, B1); PG8_BAR; PG8_SCHED;
            } else {
            PG8_LDB(B0, 0, 0); PG8_SCHED; PG8_LDA(At, 0, 0); PG8_STAGE(PG8_SA(1, 1), a1 + hstepA, voffA);
            PG8_WAIT_L(8); PG8_BAR; PG8_WAIT_L(0); PG8_MMA(0, 0, At, B0); PG8_BAR; PG8_SCHED;
            PG8_LDB(B1, 0, 1); PG8_STAGE(PG8_SB(0, 0), b2, voffB);
            PG8_BAR; PG8_WAIT_L(0); PG8_MMA(0, 1, At, B1); PG8_BAR;
            PG8_LDA(At, 0, 1); PG8_STAGE(PG8_SA(0, 0), a2, voffA);
            PG8_BAR; PG8_WAIT_L(0); PG8_MMA(1, 0, At, B0); PG8_BAR; PG8_SCHED;
            PG8_STAGE(PG8_SB(0, 1), b2 + hstepB, voffB);
            PG8_WAIT_V(6); PG8_BAR; PG8_MMA(1, 1, At, B1); PG8_BAR;
            PG8_LDB(B0, 1, 0); PG8_SCHED; PG8_LDA(At, 1, 0); PG8_STAGE(PG8_SA(0, 1), a2 + hstepA, voffA);
            PG8_WAIT_L(8); PG8_BAR; PG8_WAIT_L(0); PG8_MMA(0, 0, At, B0); PG8_BAR; PG8_SCHED;
            PG8_LDB(B1, 1, 1); PG8_STAGE(PG8_SB(1, 0), b3, voffB);
            PG8_BAR; PG8_WAIT_L(0); PG8_MMA(0, 1, At, B1); PG8_BAR;
            PG8_LDA(At, 1, 1); PG8_STAGE(PG8_SA(1, 0), a3, voffA);
            PG8_BAR; PG8_WAIT_L(0); PG8_MMA(1, 0, At, B0); PG8_BAR; PG8_SCHED;
            PG8_STAGE(PG8_SB(1, 1), b3 + hstepB, voffB);
            PG8_WAIT_V(6); PG8_BAR; PG8_MMA(1, 1, At, B1); PG8_BAR;
            }
        }
        if constexpr (ALIGN_EPI) { if (wr == 0) PG8_BAR; }
        E(acc, cur, wr, wc, fr, fq); S.done(cur);
        if (!has_next) break;
#pragma unroll
        for (int a = 0; a < 2; ++a)
#pragma unroll
            for (int b = 0; b < 2; ++b)
#pragma unroll
                for (int m = 0; m < 4; ++m)
#pragma unroll
                    for (int n = 0; n < 2; ++n) acc[a][b][m][n] = (f32x4){0.f, 0.f, 0.f, 0.f};
        cur = nxt; cA = nA; cB = nB; ++ui;
        if constexpr (ALIGN_EPI) { if (wr == 1) PG8_BAR; }
    }
    PG8_WAIT_V(0);
    if constexpr (!ALIGN_EPI) { if (wr == 0) PG8_BAR; }
    PG8_BAR;
#undef PG8_SA
#undef PG8_SB
#undef PG8_STAGE
#undef PG8_LDA
#undef PG8_LDB
#undef PG8_MMA
#undef PG8_WAIT_V
#undef PG8_WAIT_L
#undef PG8_BAR
#undef PG8_SCHED
}

template <class Epi, class Sched>
__device__ __forceinline__ void gemm_simple(const Gemm g, const Sched& S, const Epi& E) {
    const int tid = tid_opaque(), wid = __builtin_amdgcn_readfirstlane(tid >> 6), lane = tid & 63, wr = wid >> 2, wc = wid & 3, fr = lane & 15, fq = lane >> 4;
    Unit cur;
    for (int ui = 0; S.next(ui, cur); ++ui) {
        f32x4 acc[2][2][4][2];
#pragma unroll
        for (int a = 0; a < 2; ++a)
#pragma unroll
            for (int b = 0; b < 2; ++b)
#pragma unroll
                for (int m = 0; m < 4; ++m)
#pragma unroll
                    for (int n = 0; n < 2; ++n) acc[a][b][m][n] = (f32x4){0.f, 0.f, 0.f, 0.f};
        const bf16_t* Ab = g.A + (size_t)cur.pm * 256 * g.lda + (size_t)(cur.pn / g.tpg) * g.K;
        const bf16_t* Bb = g.Bt + (size_t)cur.pn * 256 * g.K;
        for (int k0 = 0; k0 < g.K; k0 += 32) {
            bf16x8 a[2][4], b[2][2];
#pragma unroll
            for (int ai = 0; ai < 2; ++ai)
#pragma unroll
                for (int m = 0; m < 4; ++m) a[ai][m] = *(const bf16x8*)(Ab + (size_t)(128 * ai + 64 * wr + 16 * m + fr) * g.lda + k0 + 8 * fq);
#pragma unroll
            for (int bj = 0; bj < 2; ++bj)
#pragma unroll
                for (int n = 0; n < 2; ++n) { const int slot = 16 * n + fr; const int rr = Epi::PERM ? perm32(slot) : slot;
                    b[bj][n] = *(const bf16x8*)(Bb + (size_t)(128 * bj + 32 * wc + rr) * g.K + k0 + 8 * fq); }
#pragma unroll
            for (int ai = 0; ai < 2; ++ai)
#pragma unroll
                for (int bj = 0; bj < 2; ++bj)
#pragma unroll
                    for (int m = 0; m < 4; ++m)
#pragma unroll
                        for (int n = 0; n < 2; ++n) acc[ai][bj][m][n] = __builtin_amdgcn_mfma_f32_16x16x32_bf16(b[bj][n], a[ai][m], acc[ai][bj][m][n], 0, 0, 0);
        }
        E(acc, cur, wr, wc, fr, fq);
    }
    __syncthreads();
}
}

constexpr int NWAVES = 8;
constexpr int N_LAUNCHES = MK_N_LAUNCHES;
constexpr int NPHASES = 9;
constexpr int D = 2048, SEQ = 4096, BATCH = 2, NMETA = 16, MR = BATCH * SEQ, INC = 5 * D, DFF = 4 * D;
constexpr int NCHUNK = MR / 64;
constexpr float NORM_EPS = 1e-6f;
constexpr int PST = 4 * D;
constexpr int PROWS = NMETA + SEQ;
__device__ __forceinline__ size_t prow(int m) { return (size_t)m + NMETA * ((m >> 12) + 1); }
constexpr int COL_VPOOL = 0, COL_VLRU = D, COL_G = 2 * D, COL_SGP = 3 * D;

constexpr size_t MiB = 1u << 20;
constexpr size_t WS_CTL = 0, CTL_ZERO_BYTES = 1 * MiB;
constexpr size_t WS_ROWSS1 = 256 * 1024, WS_ROWSS2 = 320 * 1024;
constexpr size_t WS_WIN_T = 1 * MiB;
constexpr size_t WS_XCB = WS_WIN_T, WS_H1BF = WS_WIN_T;
constexpr size_t WS_WOUT_T = 41 * MiB;
constexpr size_t WS_W1_T = 49 * MiB;
constexpr size_t WS_W2_T = 81 * MiB;
constexpr size_t WS_POOL_T = 113 * MiB;
constexpr size_t WS_GATE_T = 115 * MiB;
constexpr size_t WS_PROJ = 117 * MiB;
constexpr size_t WS_ACT = WS_PROJ;
constexpr size_t WS_U = 277 * MiB;
constexpr size_t WS_SMALL = 309 * MiB;
constexpr size_t WS_UMETA = WS_SMALL;
constexpr size_t WS_PROJMETA = WS_SMALL + 64 * 1024;
constexpr size_t WS_XCMETA = WS_SMALL + 320 * 1024;
constexpr size_t WS_HMETA = WS_SMALL + 448 * 1024;
constexpr size_t WS_NLS = WS_SMALL + 456 * 1024;
constexpr size_t WS_ACH = WS_SMALL + 1 * MiB;
constexpr size_t WS_BCH = WS_SMALL + 2 * MiB;
constexpr size_t WS_CARRY = WS_SMALL + 3 * MiB;
constexpr size_t WS_END = 313 * MiB;
constexpr int CW_TMO = 0, CW_BAR = 4096;

constexpr int RING_OFF = 0, RING_BYTES = 131072;
constexpr int LDSCTL_OFF = RING_BYTES, MISC_OFF = LDSCTL_OFF + 320;
constexpr int LDS_BYTES = 147456;

#define GAS __attribute__((address_space(1)))
#define LAS __attribute__((address_space(3)))
typedef unsigned short bf16;
typedef unsigned v4u __attribute__((ext_vector_type(4)));
typedef unsigned v2u __attribute__((ext_vector_type(2)));
typedef float f32x4 __attribute__((ext_vector_type(4)));
typedef short bf16x8 __attribute__((ext_vector_type(8)));
typedef GAS unsigned gu32;
#define RLX_AGENT __ATOMIC_RELAXED, __HIP_MEMORY_SCOPE_AGENT
#define LDS_WAIT() asm volatile("s_waitcnt lgkmcnt(0)" ::: "memory")
#define VM_WAIT() asm volatile("s_waitcnt vmcnt(0)" ::: "memory")
__device__ __forceinline__ unsigned f2bf(float f) { unsigned u = __builtin_bit_cast(unsigned, f); return (u + 0x7fffu + ((u >> 16) & 1u)) >> 16; }
__device__ __forceinline__ unsigned pk2(float lo, float hi) { return f2bf(lo) | (f2bf(hi) << 16); }
__device__ __forceinline__ float bflo(unsigned w) { return __builtin_bit_cast(float, w << 16); }
__device__ __forceinline__ float bfhi(unsigned w) { return __builtin_bit_cast(float, w & 0xffff0000u); }
__device__ __forceinline__ void unpack8(v4u w, float (&f)[8]) { f[0] = bflo(w.x); f[1] = bfhi(w.x); f[2] = bflo(w.y); f[3] = bfhi(w.y); f[4] = bflo(w.z); f[5] = bfhi(w.z); f[6] = bflo(w.w); f[7] = bfhi(w.w); }
__device__ __forceinline__ v4u pack8(const float (&f)[8]) { v4u w; w.x = pg8::cvt_pk_bf16(f[0], f[1]); w.y = pg8::cvt_pk_bf16(f[2], f[3]); w.z = pg8::cvt_pk_bf16(f[4], f[5]); w.w = pg8::cvt_pk_bf16(f[6], f[7]); return w; }
__device__ __forceinline__ float sigm(float z) { return __builtin_amdgcn_rcpf(1.f + __builtin_amdgcn_exp2f(-1.4426950408889634f * z)); }
__device__ __forceinline__ float expm1_neg(float x) {
    float p = 1.f / 5040.f; p = p * x + 1.f / 720.f; p = p * x + 1.f / 120.f; p = p * x + 1.f / 24.f; p = p * x + 1.f / 6.f; p = p * x + 0.5f; p = p * x + 1.f; p = p * x;
    const float q = __builtin_amdgcn_exp2f(1.4426950408889634f * x) - 1.f;
    return x > -0.25f ? p : q;
}
__device__ __forceinline__ float gelu_tanh(float x) { return x * sigm(1.5957691216057308f * (x + 0.044715f * x * x * x)); }
template <int S> __device__ __forceinline__ float dpp_shr(float oldv, float src) {
    return __builtin_bit_cast(float, __builtin_amdgcn_update_dpp(__builtin_bit_cast(int, oldv), __builtin_bit_cast(int, src), 0x110 + S, 0xf, 0xf, false));
}

typedef f32x4 AccT[2][2][4][2];
struct EpiProj {
    static constexpr bool PERM = true;
    bf16* O;
    __device__ __forceinline__ void operator()(AccT& acc, const pg8::Unit& u, int wr, int wc, int fr, int fq) const {
        const int row0 = u.pm * 256 + wr * 64 + fr + NMETA * ((u.pm >> 4) + 1);
        if (u.pn >= 16 && u.pn < 32) {
            const int col0 = COL_G + (u.pn - 16) * 128 + wc * 32 + 8 * fq;
#pragma unroll
            for (int ai = 0; ai < 2; ++ai)
#pragma unroll
                for (int m = 0; m < 4; ++m) { float o[8];
#pragma unroll
                    for (int e = 0; e < 8; ++e) o[e] = sigm(acc[ai][1][m][e >> 2][e & 3]) * gelu_tanh(acc[ai][0][m][e >> 2][e & 3]);
                    *(v4u*)(O + (size_t)(row0 + ai * 128 + m * 16) * PST + col0) = pack8(o); }
        } else {
            const bool sg = u.pn >= 32; const int col0 = (sg ? COL_SGP + (u.pn - 32) * 256 : u.pn * 256) + wc * 32 + 8 * fq;
#pragma unroll
            for (int ai = 0; ai < 2; ++ai)
#pragma unroll
                for (int m = 0; m < 4; ++m) { bf16* rowp = O + (size_t)(row0 + ai * 128 + m * 16) * PST + col0;
#pragma unroll
                    for (int bj = 0; bj < 2; ++bj) { float o[8];
#pragma unroll
                        for (int e = 0; e < 8; ++e) { const float v = acc[ai][bj][m][e >> 2][e & 3]; o[e] = sg ? sigm(v) : v; }
                        *(v4u*)(rowp + bj * 128) = pack8(o); } }
        }
    }
};
struct EpiH1 {
    static constexpr bool PERM = false;
    const float* x; float* out; bf16* h1bf; float* rowss;
    __device__ __forceinline__ void operator()(AccT& acc, const pg8::Unit& u, int wr, int wc, int fr, int fq) const {
        const int row0 = u.pm * 256 + wr * 64 + fr, col0 = u.pn * 256 + wc * 32 + 4 * fq;
#pragma unroll
        for (int ai = 0; ai < 2; ++ai)
#pragma unroll
            for (int m = 0; m < 4; ++m) { const int row = row0 + ai * 128 + m * 16; const size_t off = (size_t)row * D + col0; float ss = 0.f;
#pragma unroll
                for (int bj = 0; bj < 2; ++bj)
#pragma unroll
                    for (int n = 0; n < 2; ++n) { const f32x4 h = *(const f32x4*)(x + off + bj * 128 + n * 16) + acc[ai][bj][m][n];
                        *(f32x4*)(out + off + bj * 128 + n * 16) = h; ss += (h[0] * h[0] + h[1] * h[1]) + (h[2] * h[2] + h[3] * h[3]);
                        v2u w; w.x = pg8::cvt_pk_bf16(h[0], h[1]); w.y = pg8::cvt_pk_bf16(h[2], h[3]); *(v2u*)(h1bf + off + bj * 128 + n * 16) = w; }
                ss += __shfl_xor(ss, 16); ss += __shfl_xor(ss, 32);
                if (fq == 0) atomicAdd(rowss + row, ss); }
    }
};
struct EpiAct {
    static constexpr bool PERM = true;
    bf16* O; const float* rowss;
    __device__ __forceinline__ void operator()(AccT& acc, const pg8::Unit& u, int wr, int wc, int fr, int fq) const {
        const int row0 = u.pm * 256 + wr * 64 + fr, col0 = u.pn * 256 + wc * 32 + 8 * fq;
#pragma unroll
        for (int ai = 0; ai < 2; ++ai)
#pragma unroll
            for (int m = 0; m < 4; ++m) { const int row = row0 + ai * 128 + m * 16; const float rs = rsqrtf(rowss[row] * (1.f / D) + NORM_EPS); bf16* rowp = O + (size_t)row * DFF + col0;
#pragma unroll
                for (int bj = 0; bj < 2; ++bj) { float o[8];
#pragma unroll
                    for (int e = 0; e < 8; ++e) { const float v = fmaxf(rs * acc[ai][bj][m][e >> 2][e & 3], 0.f); o[e] = v * v; }
                    *(v4u*)(rowp + bj * 128) = pack8(o); } }
    }
};
struct EpiOut {
    static constexpr bool PERM = false;
    float* out; float* rowss;
    __device__ __forceinline__ void operator()(AccT& acc, const pg8::Unit& u, int wr, int wc, int fr, int fq) const {
        const int row0 = u.pm * 256 + wr * 64 + fr, col0 = u.pn * 256 + wc * 32 + 4 * fq;
#pragma unroll
        for (int ai = 0; ai < 2; ++ai)
#pragma unroll
            for (int m = 0; m < 4; ++m) { const int row = row0 + ai * 128 + m * 16; const size_t off = (size_t)row * D + col0; float ss = 0.f;
#pragma unroll
                for (int bj = 0; bj < 2; ++bj)
#pragma unroll
                    for (int n = 0; n < 2; ++n) { const f32x4 h = *(const f32x4*)(out + off + bj * 128 + n * 16) + acc[ai][bj][m][n];
                        *(f32x4*)(out + off + bj * 128 + n * 16) = h; ss += (h[0] * h[0] + h[1] * h[1]) + (h[2] * h[2] + h[3] * h[3]); }
                ss += __shfl_xor(ss, 16); ss += __shfl_xor(ss, 32);
                if (fq == 0) atomicAdd(rowss + row, ss); }
    }
};

#define XB_TMO      128
#define XB_XCNT(j)  (256  + 64 * (j))
#define XB_XSUB(j)  (1280 + 64 * (j))
#define XB_XGEN(j)  (2304 + 64 * (j))
#define XB_TOP      3328
#define XB_TOPGEN   3392
#define XCD_BAR_WORDS 3456
#define XB_SPIN_CAP (1u << 18)
__device__ __forceinline__ unsigned xb_ld(unsigned* p)              { return __hip_atomic_load(p, __ATOMIC_RELAXED, __HIP_MEMORY_SCOPE_AGENT); }
__device__ __forceinline__ unsigned xb_add(unsigned* p, unsigned v) { return __hip_atomic_fetch_add(p, v, __ATOMIC_RELAXED, __HIP_MEMORY_SCOPE_AGENT); }
__device__ __forceinline__ unsigned xb_xcc_id() { return (unsigned)__builtin_amdgcn_s_getreg((3 << 11) | 20) & 0xFu; }
#define XB_SPIN(cond, bar) do { unsigned _sp = 0; while (cond) { __builtin_amdgcn_s_sleep(1); \
    if ((++_sp & 255u) == 0u) { if (xb_ld(&(bar)[XB_TMO])) break; if (_sp > XB_SPIN_CAP) { atomicAdd(&(bar)[XB_TMO], 1u); break; } } } } while (0)
struct XcdBarrier { unsigned* bar; unsigned x; volatile LAS unsigned* st; };
__device__ __forceinline__ XcdBarrier xcd_barrier_post(unsigned* bar, volatile LAS unsigned* st) {
    XcdBarrier b; b.bar = bar; b.x = xb_xcc_id(); b.st = st;
    if (threadIdx.x == 0) (void)xb_add(&bar[XB_XCNT(b.x)], 1u);
    return b;
}
__device__ __forceinline__ void xcd_barrier_complete(unsigned* bar, unsigned x, unsigned& nloc, unsigned& nx) {
    const unsigned G = gridDim.x * gridDim.y * gridDim.z;
    unsigned sum, cnt, mine, sp = 0u;
    for (;;) {
        sum = 0u; cnt = 0u; mine = 0u;
#pragma unroll
        for (unsigned j = 0; j < 16; ++j) { const unsigned c = xb_ld(&bar[XB_XCNT(j)]); sum += c; cnt += (c > 0u) ? 1u : 0u; mine = (j == x) ? c : mine; }
        if (sum == G) break;
        __builtin_amdgcn_s_sleep(1);
        if ((++sp & 255u) == 0u) { if (xb_ld(&bar[XB_TMO])) break; if (sp > XB_SPIN_CAP) { atomicAdd(&bar[XB_TMO], 1u); break; } }
    }
    nloc = mine > 0u ? mine : 1u; nx = cnt > 0u ? cnt : 1u;
}
__device__ __forceinline__ void xcd_barrier(const XcdBarrier& b) {
    asm volatile("s_waitcnt vmcnt(0)" ::: "memory");
    __syncthreads();
    if (threadIdx.x == 0) {
        unsigned* bar = b.bar;
        __builtin_amdgcn_s_waitcnt(0);
        unsigned nloc = b.st[0], nx = b.st[1];
        if (nloc == 0u) { xcd_barrier_complete(bar, b.x, nloc, nx); b.st[0] = nloc; b.st[1] = nx; }
        const unsigned old = xb_add(&bar[XB_XSUB(b.x)], 1u);
        const unsigned gen = old / nloc;
        if (old + 1u == (gen + 1u) * nloc) {
            __builtin_amdgcn_fence(__ATOMIC_RELEASE, "agent");
            asm volatile("s_waitcnt vmcnt(0)" ::: "memory");
            const unsigned og = xb_add(&bar[XB_TOP], 1u);
            const unsigned tg = og / nx;
            if (og + 1u == (tg + 1u) * nx) xb_add(&bar[XB_TOPGEN], 1u);
            else XB_SPIN(xb_ld(&bar[XB_TOPGEN]) == tg, bar);
            __builtin_amdgcn_fence(__ATOMIC_ACQUIRE, "agent");
            xb_add(&bar[XB_XGEN(b.x)], 1u);
            asm volatile("s_waitcnt vmcnt(0)" ::: "memory");
        } else {
            XB_SPIN(xb_ld(&bar[XB_XGEN(b.x)]) == gen, bar);
            __builtin_amdgcn_fence(__ATOMIC_ACQUIRE, "agent");
            asm volatile("s_waitcnt vmcnt(0)" ::: "memory");
        }
    }
    __syncthreads();
}

__device__ __forceinline__ float wave_sum(float v) {
#pragma unroll
    for (int o = 1; o < 64; o <<= 1) v += __shfl_xor(v, o);
    return v;
}
struct TrItem { const float* W; bf16* WT; const float* scale; int ldw, ldt, k0, n0, dr, mode, fbase, fmul; };
__device__ __forceinline__ void p0_issue(const TrItem& t, f32x4 (&v)[8], int ln) {
    const int r = ln >> 3, c4 = ln & 7;
#pragma unroll
    for (int i = 0; i < 8; ++i) v[i] = *(const f32x4*)(t.W + (size_t)(t.k0 + 8 * i + r) * t.ldw + t.n0 + 4 * c4);
}
__device__ __forceinline__ void p0_finish(const TrItem& t, const f32x4 (&v)[8], LAS float* scr, int ln) {
    const int r = ln >> 3, c4 = ln & 7;
#pragma unroll
    for (int i = 0; i < 8; ++i) { const int kk = 8 * i + r; const float sc = t.scale ? t.scale[t.k0 + kk] : 1.f;
#pragma unroll
        for (int j = 0; j < 4; ++j) scr[kk * 33 + 4 * c4 + j] = v[i][j] * sc; }
    LDS_WAIT(); asm volatile("" ::: "memory");
    const int c = ln & 7;
#pragma unroll
    for (int j = 0; j < 4; ++j) { const int n = (ln >> 3) + 8 * j; const LAS float* s = scr + (8 * c) * 33 + n;
        v4u o; o.x = pk2(s[0 * 33], s[1 * 33]); o.y = pk2(s[2 * 33], s[3 * 33]); o.z = pk2(s[4 * 33], s[5 * 33]); o.w = pk2(s[6 * 33], s[7 * 33]);
        const int k = t.k0 + 8 * c;
        if (t.mode == 0) *(v4u*)(t.WT + (size_t)(t.dr + n) * t.ldt + k) = o;
        else { const int ch = t.dr + n, w8 = ch >> 5, i5 = ch & 31, f = t.fbase + (k >> 5) * t.fmul + ((i5 >> 2) & 1), fr = ((i5 >> 3) << 2) | (i5 & 3), fq = (k >> 3) & 3;
            *(v4u*)(t.WT + ((size_t)(w8 * 32 + f) * 64 + fq * 16 + fr) * 8) = o; } }
    LDS_WAIT(); asm volatile("" ::: "memory");
}
__device__ __forceinline__ void rms_row_to_bf16(const float* xrow, const float* g, bf16* orow, int lane) {
    const f32x4* xr = (const f32x4*)xrow + lane; const f32x4* gr = (const f32x4*)g + lane;
    f32x4 v[8]; float s = 0.f;
#pragma unroll
    for (int j = 0; j < 8; ++j) { v[j] = xr[64 * j]; s += (v[j][0] * v[j][0] + v[j][1] * v[j][1]) + (v[j][2] * v[j][2] + v[j][3] * v[j][3]); }
    const float rs = rsqrtf(wave_sum(s) * (1.f / D) + NORM_EPS);
    v2u* o8 = (v2u*)orow + lane;
#pragma unroll
    for (int j = 0; j < 8; ++j) { const f32x4 gg = gr[64 * j]; v2u w; w.x = pk2(v[j][0] * rs * gg[0], v[j][1] * rs * gg[1]); w.y = pk2(v[j][2] * rs * gg[2], v[j][3] * rs * gg[3]); o8[64 * j] = w; }
}
__device__ __forceinline__ void load_row8(const bf16* proj, const float* pmeta, int b, int tpos, int cg, int c0, float (&f)[8]) {
    if (tpos >= 0) unpack8(*(const v4u*)(proj + (size_t)(b * SEQ + tpos) * PST + cg * D + c0), f);
    else { const float* p = pmeta + (size_t)(NMETA + tpos) * (2 * D) + cg * D + c0; const f32x4 a = *(const f32x4*)p, c = *(const f32x4*)(p + 4);
#pragma unroll
        for (int e = 0; e < 4; ++e) { f[e] = a[e]; f[4 + e] = c[e]; } }
}


constexpr int MX_AD = 0, MX_AX = 65536;
__device__ __forceinline__ v4u load_row8p(const bf16* proj, int b, int tpos, int cg, int c0) {
    return *(const v4u*)(proj + (size_t)(b * PROWS + NMETA + tpos) * PST + cg * D + c0);
}
template <int W> __device__ __forceinline__ void build_d(const bf16* proj, LAS unsigned char* lds, int b, int tl0, int g, int t) {
    const int kc = t & 63, rb = t >> 6, c0 = 512 * g + 8 * kc;
    v4u v[W + 7];
#pragma unroll
    for (int i = 0; i < W + 7; ++i) v[i] = load_row8p(proj, b, tl0 + 8 * rb - (W - 1) + i, 0, c0);
    __builtin_amdgcn_sched_barrier(0);
    float s[8], f[8], o[8];
#pragma unroll
    for (int e = 0; e < 8; ++e) s[e] = 0.f;
#pragma unroll
    for (int i = 0; i < W; ++i) { unpack8(v[i], f);
#pragma unroll
        for (int e = 0; e < 8; ++e) s[e] += f[e]; }
#pragma unroll
    for (int r = 0; r < 8; ++r) { unpack8(v[r + W - 1], f);
#pragma unroll
        for (int e = 0; e < 8; ++e) o[e] = s[e] * (1.f / W) - f[e];
        const int row = 8 * rb + r;
        *(LAS v4u*)(lds + MX_AD + row * 1024 + ((kc ^ (row & 15)) << 4)) = pack8(o);
        if (r < 7) { float fo[8]; unpack8(v[r + W], f); unpack8(v[r], fo);
#pragma unroll
            for (int e = 0; e < 8; ++e) s[e] += f[e] - fo[e]; } }
}
__device__ __forceinline__ void build_xc(const bf16* proj, const float* conv_w, const float* conv_b, LAS unsigned char* lds, int b, int tl0, int s, int t) {
    const int kc = t & 31, rb = t >> 5, c0 = 256 * s + 8 * kc;
    v4u v[7];
#pragma unroll
    for (int i = 0; i < 7; ++i) v[i] = load_row8p(proj, b, tl0 + 4 * rb - 3 + i, 1, c0);
    __builtin_amdgcn_sched_barrier(0);
    float o[4][8], f[8];
    { const f32x4 a = *(const f32x4*)(conv_b + c0), c = *(const f32x4*)(conv_b + c0 + 4);
#pragma unroll
      for (int r = 0; r < 4; ++r)
#pragma unroll
          for (int e = 0; e < 4; ++e) { o[r][e] = a[e]; o[r][4 + e] = c[e]; } }
#pragma unroll
    for (int k = 0; k < 4; ++k) { const f32x4 a = *(const f32x4*)(conv_w + k * D + c0), c = *(const f32x4*)(conv_w + k * D + c0 + 4);
#pragma unroll
        for (int r = 0; r < 4; ++r) { unpack8(v[r + k], f);
#pragma unroll
            for (int e = 0; e < 4; ++e) { o[r][e] += a[e] * f[e]; o[r][4 + e] += c[e] * f[4 + e]; } } }
#pragma unroll
    for (int r = 0; r < 4; ++r) { const int row = 4 * rb + r; *(LAS v4u*)(lds + MX_AX + row * 512 + ((kc ^ (row & 15)) << 4)) = pack8(o[r]); }
}
#define MX_BPTR(f) ((f) < 32 ? pB + (f) * 512 : gA + ((f) - 32) * 512)
template <int F0, int F1> __device__ __forceinline__ void mixer_prefetch(bf16x8 (&ring)[16], const bf16* POOL_T, const bf16* GATE_T, int chs, int ln) {
    const bf16* pB = POOL_T + ((size_t)(chs >> 5) * 32 * 64 + ln) * 8; const bf16* gA = GATE_T + ((size_t)(chs >> 5) * 32 * 64 + ln) * 8;
#pragma unroll
    for (int f = F0; f < F1; ++f) ring[f] = *(const bf16x8*)MX_BPTR(f);
}
__device__ __forceinline__ void mixer_wave(bf16x8 (&ring)[16], LAS unsigned char* lds, const bf16* POOL_T, const bf16* GATE_T, const bf16* PROJ, const float* pscale, const float* ba, const float* bx, const float* nls,
                                           bf16* M0, bf16* M1, float* ach, float* bch, int chunk, int chs, int wv, int ln, int probe) {
    const int fr = ln & 15, fq = ln >> 4;
    const bf16* pB = POOL_T + ((size_t)(chs >> 5) * 32 * 64 + ln) * 8; const bf16* gA = GATE_T + ((size_t)(chs >> 5) * 32 * 64 + ln) * 8;
    f32x4 accp[4][2], accr[4][2], acci[4][2];
#pragma unroll
    for (int m = 0; m < 4; ++m)
#pragma unroll
        for (int n = 0; n < 2; ++n) { accp[m][n] = (f32x4){0.f, 0.f, 0.f, 0.f}; accr[m][n] = (f32x4){0.f, 0.f, 0.f, 0.f}; acci[m][n] = (f32x4){0.f, 0.f, 0.f, 0.f}; }
    const LAS unsigned char* ad = lds + MX_AD + fr * 1024;
    const LAS unsigned char* ax = lds + MX_AX + fr * 512;
#define MX_APTR(q, m) ((q) < 16 ? ad + (m) * 16384 + (((4 * (q) + fq) ^ fr) << 4) : ax + (m) * 8192 + (((4 * ((q) - 16) + fq) ^ fr) << 4))
    bf16x8 an[4];
#pragma unroll
    for (int m = 0; m < 4; ++m) an[m] = *(const LAS bf16x8*)MX_APTR(0, m);
#pragma unroll
    for (int ks = 0; ks < 16; ++ks) {
        const bf16x8 b0 = ring[(2 * ks) & 15], b1 = ring[(2 * ks + 1) & 15];
        bf16x8 a[4];
#pragma unroll
        for (int m = 0; m < 4; ++m) a[m] = an[m];
#pragma unroll
        for (int m = 0; m < 4; ++m) an[m] = *(const LAS bf16x8*)MX_APTR(ks + 1, m);
        __builtin_amdgcn_sched_barrier(0);
#pragma unroll
        for (int m = 0; m < 4; ++m) { accp[m][0] = __builtin_amdgcn_mfma_f32_16x16x32_bf16(b0, a[m], accp[m][0], 0, 0, 0); accp[m][1] = __builtin_amdgcn_mfma_f32_16x16x32_bf16(b1, a[m], accp[m][1], 0, 0, 0); }
        ring[(2 * ks) & 15] = *(const bf16x8*)MX_BPTR(2 * ks + 16); ring[(2 * ks + 1) & 15] = *(const bf16x8*)MX_BPTR(2 * ks + 17);
    }
#pragma unroll
    for (int ks = 0; ks < 8; ++ks) {
        const bf16x8 r0 = ring[(4 * ks) & 15], r1 = ring[(4 * ks + 1) & 15], i0 = ring[(4 * ks + 2) & 15], i1 = ring[(4 * ks + 3) & 15];
        bf16x8 a[4];
#pragma unroll
        for (int m = 0; m < 4; ++m) a[m] = an[m];
        if (ks < 7) {
#pragma unroll
            for (int m = 0; m < 4; ++m) an[m] = *(const LAS bf16x8*)MX_APTR(16 + ks + 1, m); }
        __builtin_amdgcn_sched_barrier(0);
#pragma unroll
        for (int m = 0; m < 4; ++m) {
            accr[m][0] = __builtin_amdgcn_mfma_f32_16x16x32_bf16(r0, a[m], accr[m][0], 0, 0, 0); accr[m][1] = __builtin_amdgcn_mfma_f32_16x16x32_bf16(r1, a[m], accr[m][1], 0, 0, 0);
            acci[m][0] = __builtin_amdgcn_mfma_f32_16x16x32_bf16(i0, a[m], acci[m][0], 0, 0, 0); acci[m][1] = __builtin_amdgcn_mfma_f32_16x16x32_bf16(i1, a[m], acci[m][1], 0, 0, 0); }
        if (ks < 4) {
#pragma unroll
            for (int q = 0; q < 4; ++q) ring[(4 * ks + q) & 15] = *(const bf16x8*)MX_BPTR(32 + 4 * ks + q + 16); }
    }
    if (probe) {
#pragma unroll
        for (int m = 0; m < 4; ++m)
#pragma unroll
            for (int n = 0; n < 2; ++n) asm volatile("" :: "v"(accp[m][n]), "v"(accr[m][n]), "v"(acci[m][n]));
        return; }
    const int ch0 = chs + 8 * fq;
    float cba[8], cbx[8], cnl[8];
    { const f32x4 a0 = *(const f32x4*)(ba + ch0), a1 = *(const f32x4*)(ba + ch0 + 4), b0 = *(const f32x4*)(bx + ch0), b1 = *(const f32x4*)(bx + ch0 + 4), c0 = *(const f32x4*)(nls + ch0), c1 = *(const f32x4*)(nls + ch0 + 4);
#pragma unroll
      for (int e = 0; e < 4; ++e) { cba[e] = a0[e]; cba[4 + e] = a1[e]; cbx[e] = b0[e]; cbx[4 + e] = b1[e]; cnl[e] = c0[e]; cnl[4 + e] = c1[e]; } }
#pragma unroll
    for (int m = 0; m < 4; ++m) { float xc[8]; unpack8(*(const LAS v4u*)(ax + m * 8192 + (((4 * wv + fq) ^ fr) << 4)), xc);
#pragma unroll
        for (int e = 0; e < 8; ++e) { const float r = sigm(accr[m][e >> 2][e & 3] + cba[e]), ig = sigm(acci[m][e >> 2][e & 3] + cbx[e]);
            const float t = expm1_neg(cnl[e] * r);
            accr[m][e >> 2][e & 3] = 1.f + t; acci[m][e >> 2][e & 3] = __builtin_amdgcn_sqrtf(-t * (2.f + t)) * ig * xc[e]; } }
#pragma unroll
    for (int m = 0; m < 4; ++m)
#pragma unroll
        for (int e = 0; e < 8; ++e) { float A = accr[m][e >> 2][e & 3], B = acci[m][e >> 2][e & 3], As, Bs;
            As = dpp_shr<1>(1.f, A); Bs = dpp_shr<1>(0.f, B); B = A * Bs + B; A = A * As;
            As = dpp_shr<2>(1.f, A); Bs = dpp_shr<2>(0.f, B); B = A * Bs + B; A = A * As;
            As = dpp_shr<4>(1.f, A); Bs = dpp_shr<4>(0.f, B); B = A * Bs + B; A = A * As;
            As = dpp_shr<8>(1.f, A); Bs = dpp_shr<8>(0.f, B); B = A * Bs + B; A = A * As;
            accr[m][e >> 2][e & 3] = A; acci[m][e >> 2][e & 3] = B; }
    const int lane15 = ln | 15;
#pragma unroll
    for (int m = 1; m < 4; ++m)
#pragma unroll
        for (int e = 0; e < 8; ++e) { const float CA = __shfl(accr[m - 1][e >> 2][e & 3], lane15), CB = __shfl(acci[m - 1][e >> 2][e & 3], lane15);
            const float A = accr[m][e >> 2][e & 3], B = acci[m][e >> 2][e & 3];
            acci[m][e >> 2][e & 3] = A * CB + B; accr[m][e >> 2][e & 3] = A * CA; }
    float ps[8];
    { const f32x4 a = *(const f32x4*)(pscale + ch0), c = *(const f32x4*)(pscale + ch0 + 4);
#pragma unroll
      for (int e = 0; e < 4; ++e) { ps[e] = a[e]; ps[4 + e] = c[e]; } }
#pragma unroll
    for (int m = 0; m < 4; ++m) { const size_t row = (size_t)chunk * 64 + 16 * m + fr; const bf16* rowp = PROJ + prow((int)row) * PST + ch0; float gg[8], sg[8], o0[8], o1[8];
        unpack8(*(const v4u*)(rowp + COL_G), gg); unpack8(*(const v4u*)(rowp + COL_SGP), sg);
#pragma unroll
        for (int e = 0; e < 8; ++e) { o0[e] = sg[e] * ps[e] * accp[m][e >> 2][e & 3] + gg[e] * acci[m][e >> 2][e & 3]; o1[e] = gg[e] * accr[m][e >> 2][e & 3]; }
        *(v4u*)(M0 + row * D + ch0) = pack8(o0); *(v4u*)(M1 + row * D + ch0) = pack8(o1); }
    if (fr == 15) { float* pa = ach + (size_t)chunk * D + ch0; float* pb = bch + (size_t)chunk * D + ch0;
        *(f32x4*)pa = accr[3][0]; *(f32x4*)(pa + 4) = accr[3][1]; *(f32x4*)pb = acci[3][0]; *(f32x4*)(pb + 4) = acci[3][1]; }
}

struct Args { const float* in[18]; float* out; unsigned char* ws; int ph_lo, ph_hi, li, pad; };
__global__ void __launch_bounds__(NWAVES * 64, 2) fwd_kernel(Args args) {
    extern __shared__ __attribute__((aligned(16))) unsigned char lds_raw[];
    LAS unsigned char* lds = (LAS unsigned char*)lds_raw;
    volatile LAS unsigned* MISC = (volatile LAS unsigned*)(lds + MISC_OFF);
#define tid (pg8::tid_opaque())
#define lane (pg8::tid_opaque() & 63)
#define wave (__builtin_amdgcn_readfirstlane(pg8::tid_opaque() >> 6))
    const int G = gridDim.x; const int bx = blockIdx.x; const int vcu = (G % 8 == 0) ? (bx % 8) * (G / 8) + bx / 8 : bx;
    unsigned char* ws = args.ws;
    gu32* ctl = (gu32*)(ws + WS_CTL);
    const float* x = args.in[0]; const float* meta = args.in[1]; const float* norm1_g = args.in[2]; const float* w_in = args.in[3];
    const float* pool_w = args.in[4]; const float* pool_scale = args.in[5]; const float* conv_w = args.in[6]; const float* conv_b = args.in[7];
    const float* gate_a_w = args.in[8]; const float* gate_a_b = args.in[9]; const float* gate_x_w = args.in[10]; const float* gate_x_b = args.in[11];
    const float* lru_lambda = args.in[12]; const float* w_out = args.in[13]; const float* norm2_g = args.in[14]; const float* mlp_w1 = args.in[15];
    const float* mlp_w2 = args.in[16]; const float* final_g = args.in[17];
    float* out = args.out;
    bf16* WIN_T = (bf16*)(ws + WS_WIN_T); bf16* WOUT_T = (bf16*)(ws + WS_WOUT_T); bf16* W1_T = (bf16*)(ws + WS_W1_T); bf16* W2_T = (bf16*)(ws + WS_W2_T);
    bf16* POOL_T = (bf16*)(ws + WS_POOL_T); bf16* GATE_T = (bf16*)(ws + WS_GATE_T);
    bf16* PROJ = (bf16*)(ws + WS_PROJ); bf16* ACT = (bf16*)(ws + WS_ACT); bf16* U = (bf16*)(ws + WS_U); bf16* MBUF0 = U;
    bf16* MBUF1 = (bf16*)(ws + WS_XCB); bf16* H1BF = (bf16*)(ws + WS_H1BF); bf16* UMETA = (bf16*)(ws + WS_UMETA);
    float* PROJMETA = (float*)(ws + WS_PROJMETA); float* HMETA = (float*)(ws + WS_HMETA); float* NLS = (float*)(ws + WS_NLS);
    float* ACH = (float*)(ws + WS_ACH); float* BCH = (float*)(ws + WS_BCH); float* CARRY = (float*)(ws + WS_CARRY);
    float* ROWSS1 = (float*)(ws + WS_ROWSS1); float* ROWSS2 = (float*)(ws + WS_ROWSS2);

    for (int u = tid; u < (LDS_BYTES - LDSCTL_OFF) / 4; u += NWAVES * 64) ((LAS unsigned*)(lds + LDSCTL_OFF))[u] = 0u;
    __syncthreads();
    XcdBarrier bar; bar.bar = (unsigned*)(ctl + CW_BAR); bar.x = 0; bar.st = nullptr;
    if (N_LAUNCHES == 1) bar = xcd_barrier_post((unsigned*)(ctl + CW_BAR), MISC + 8);
#ifndef MK_TS
#define MK_TS -1
#endif
#define STAMP(k) do { if (MK_TS >= 0 && bx == 0 && tid == 0) { const unsigned long long t_ = __builtin_amdgcn_s_memrealtime(); MISC[16 + 2 * (k)] = (unsigned)t_; MISC[17 + 2 * (k)] = (unsigned)(t_ >> 32); } } while (0)
#define GRID_BAR() do { if (N_LAUNCHES == 1) xcd_barrier(bar); } while (0)
    const int lo = args.ph_lo, hi = args.ph_hi;
#ifndef MK_PHASE_MASK
#define MK_PHASE_MASK 0x1ff
#endif
#ifndef MK_REP_MASK
#define MK_REP_MASK 0
#endif
#define REP(k) for (int rep_ = 0; rep_ < 1 + ((MK_REP_MASK >> (k)) & 1); ++rep_)
#define IN(k) (((MK_PHASE_MASK >> (k)) & 1) && lo <= (k) && (k) < hi)
#define BOTH(k) (IN(k) && IN((k) + 1))
#if MK_SIMPLE_GEMM
#define RUN_GEMM(EpiT, g, S, E) pg8::gemm_simple<EpiT, pg8::StaticOrder>(g, S, E)
#else
#define RUN_GEMM(EpiT, g, S, E) pg8::gemm_phase<EpiT, pg8::StaticOrder, true, true>(lds + RING_OFF, g, S, E)
#endif

    constexpr int I_IN = 32 * 320, I_OUT = 32 * 64, I_1 = 32 * 256, I_2 = 128 * 64, I_P = 4 * 8 * 16, I_G = 2 * 8 * 4 * 8;
    constexpr int N_EARLY = I_IN + I_OUT + I_P + I_G, NITEMS = N_EARLY + I_1 + I_2;
    auto decode = [&](int it, int it_end, TrItem& t) -> bool {
        if (it >= it_end) return false;
        int r = it; t.scale = nullptr; t.mode = 0; t.fbase = 0; t.fmul = 0;
        if (r < I_IN) { const int kb = r / 320, nb = r % 320, n0 = 32 * nb; int dr = n0;
            if (n0 >= 4 * D) { const int ch = n0 - 4 * D; dr = 256 * (16 + (ch >> 7)) + 128 + (ch & 127); }
            else if (n0 >= 3 * D) dr = 4 * D + (n0 - 3 * D);
            else if (n0 >= 2 * D) { const int ch = n0 - 2 * D; dr = 256 * (16 + (ch >> 7)) + (ch & 127); }
            t.W = w_in; t.ldw = INC; t.k0 = 64 * kb; t.n0 = n0; t.WT = WIN_T; t.ldt = D; t.dr = dr; return true; } r -= I_IN;
        if (r < I_OUT) { const int kb = r / 64, nb = r % 64; t.W = w_out; t.ldw = D; t.k0 = 64 * kb; t.n0 = 32 * nb; t.WT = WOUT_T; t.ldt = D; t.dr = 32 * nb; return true; } r -= I_OUT;
        if (r < I_P) { const int g = r / 128, q = r % 128, kb = q / 16, nb = q % 16; t.W = pool_w + (size_t)g * 512 * 512; t.ldw = 512; t.k0 = 64 * kb; t.n0 = 32 * nb; t.WT = POOL_T; t.ldt = 512; t.dr = 512 * g + 32 * nb;
            t.mode = 1; t.fbase = 0; t.fmul = 2; return true; } r -= I_P;
        if (r < I_G) { const int gate = r / 256, q = r % 256, h = q / 32, q2 = q % 32, kb = q2 / 8, nb = q2 % 8, j0 = 32 * nb;
            t.W = (gate ? gate_x_w : gate_a_w) + (size_t)h * 65536; t.ldw = 256; t.k0 = 64 * kb; t.n0 = j0; t.WT = GATE_T; t.ldt = 256; t.dr = 256 * h + j0; t.mode = 1; t.fbase = 2 * gate; t.fmul = 4; return true; } r -= I_G;
        if (r < I_1) { const int kb = r / 256, nb = r % 256; t.W = mlp_w1; t.ldw = DFF; t.k0 = 64 * kb; t.n0 = 32 * nb; t.WT = W1_T; t.ldt = D; t.dr = 32 * nb; t.scale = norm2_g; return true; } r -= I_1;
        { const int kb = r / 64, nb = r % 64; t.W = mlp_w2; t.ldw = D; t.k0 = 64 * kb; t.n0 = 32 * nb; t.WT = W2_T; t.ldt = DFF; t.dr = 32 * nb; return true; }
    };
    auto run_items = [&](int it_begin, int it_end) {
        LAS float* scr = (LAS float*)(lds + RING_OFF + wave * 16384);
        const int gw = vcu * NWAVES + wave, NGW = G * NWAVES, ln = lane;
        TrItem tc, tn; f32x4 vc[8], vn[8]; int it = it_begin + gw;
        if (decode(it, it_end, tc)) { p0_issue(tc, vc, ln);
            for (;;) { it += NGW; const bool has = decode(it, it_end, tn);
                if (has) p0_issue(tn, vn, ln);
                p0_finish(tc, vc, scr, ln);
                if (!has) break;
                tc = tn;
#pragma unroll
                for (int i = 0; i < 8; ++i) vc[i] = vn[i]; } }
    };

    STAMP(0);
    if (IN(0)) { REP(0) {
        const int gw = vcu * NWAVES + wave, NGW = G * NWAVES;
        run_items(0, N_EARLY);
        for (int m = gw; m < MR + NMETA; m += NGW) {
            if (m < MR) rms_row_to_bf16(x + (size_t)m * D, norm1_g, U + (size_t)m * D, lane);
            else rms_row_to_bf16(meta + (size_t)(m - MR) * D, norm1_g, UMETA + (size_t)(m - MR) * D, lane);
        }
        if (bx == 0) for (int c = tid; c < D; c += NWAVES * 64) NLS[c] = -8.f * log1pf(expf(-lru_lambda[c]));
        }
        if (BOTH(0)) GRID_BAR();
        STAMP(1);
    }

    if (IN(1)) {
        REP(1) { pg8::Gemm g{U, WIN_T, D, D, 1 << 30}; pg8::StaticOrder S; S.init(MR, INC, G, bx); EpiProj E{PROJ};
          RUN_GEMM(EpiProj, g, S, E); }
        __syncthreads();
        for (int nb = bx; nb < 256; nb += G) {
            const int fr = lane & 15, fq = lane >> 4, n0 = 16 * nb;
            f32x4 acc = (f32x4){0.f, 0.f, 0.f, 0.f};
#pragma unroll
            for (int kk = 0; kk < 8; ++kk) { const int k = 256 * wave + 32 * kk + 8 * fq;
                const bf16x8 a = *(const bf16x8*)(UMETA + (size_t)fr * D + k), b = *(const bf16x8*)(WIN_T + (size_t)(n0 + fr) * D + k);
                acc = __builtin_amdgcn_mfma_f32_16x16x32_bf16(a, b, acc, 0, 0, 0); }
            LAS f32x4* red = (LAS f32x4*)(lds + RING_OFF);
            red[wave * 64 + lane] = acc;
            __syncthreads();
            if (wave == 0) { f32x4 s = red[lane];
#pragma unroll
                for (int w = 1; w < 8; ++w) s += red[w * 64 + lane];
#pragma unroll
                for (int r = 0; r < 4; ++r) { PROJMETA[(size_t)(4 * fq + r) * (2 * D) + n0 + fr] = s[r]; const bf16 hb = (bf16)f2bf(s[r]);
                    PROJ[(size_t)(4 * fq + r) * PST + n0 + fr] = hb; PROJ[(size_t)(PROWS + 4 * fq + r) * PST + n0 + fr] = hb; } }
            __syncthreads();
        }
        if (BOTH(1)) GRID_BAR();
        STAMP(2);
    }

    if (IN(2)) {
#ifndef MK_PROBE
#define MK_PROBE 0
#endif
        for (int pass_ = (MK_PROBE ? 0 : 1); pass_ < 2; ++pass_) for (int t = bx; t < NCHUNK * 8; t += G) {
            int probe = (pass_ == 0); asm volatile("" : "+s"(probe));
            const int s = t & 7, chunk = t >> 3, g = s >> 1, b = chunk >> 6, tl0 = (chunk & 63) * 64;
            bf16x8 ring[16];
            if (!(probe && MK_PROBE == 3)) mixer_prefetch<0, 8>(ring, POOL_T, GATE_T, 256 * s + 32 * wave, lane);
            if (!(probe && MK_PROBE == 2)) { const int tt = tid;
              if (g == 0) build_d<2>(PROJ, lds, b, tl0, g, tt); else if (g == 1) build_d<4>(PROJ, lds, b, tl0, g, tt);
              else if (g == 2) build_d<8>(PROJ, lds, b, tl0, g, tt); else build_d<16>(PROJ, lds, b, tl0, g, tt);
              build_xc(PROJ, conv_w, conv_b, lds, b, tl0, s, tt); }
            if (!(probe && MK_PROBE == 3)) mixer_prefetch<8, 16>(ring, POOL_T, GATE_T, 256 * s + 32 * wave, lane);
            __syncthreads();
            if (!(probe && MK_PROBE == 3)) { const int wv = wave; mixer_wave(ring, lds, POOL_T, GATE_T, PROJ, pool_scale, gate_a_b, gate_x_b, NLS, MBUF0, MBUF1, ACH, BCH, chunk, 256 * s + 32 * wv, wv, lane, probe); }
            __syncthreads();
        }
        if (BOTH(2)) GRID_BAR();
        STAMP(3);
    }

    if (IN(3)) {
        for (int cb = bx; cb < D / 8; cb += G) {
            const int h = cb >> 5, j0 = (8 * cb) & 255;
            LAS float* xs = (LAS float*)(lds + RING_OFF);
            LAS float* rg = (LAS float*)(lds + RING_OFF + 16384);
            LAS float* ab = (LAS float*)(lds + RING_OFF + 32768);
            { float tv[4];
#pragma unroll
              for (int q = 0; q < 4; ++q) { const int e = tid + 512 * q, arr = e >> 10, b = (e >> 9) & 1, k = (e >> 3) & 63, jj = e & 7; tv[q] = (arr ? BCH : ACH)[(size_t)(b * 64 + k) * D + 8 * cb + jj]; }
#pragma unroll
              for (int q = 0; q < 4; ++q) ab[tid + 512 * q] = tv[q]; }
            for (int i = tid; i < 16 * 256; i += NWAVES * 64) { const int p = i >> 8, c = 256 * h + (i & 255); float sx = conv_b[c];
                for (int k = 0; k < 4; ++k) { const int q = p - 3 + k; if (q >= 0) sx += conv_w[k * D + c] * PROJMETA[(size_t)q * (2 * D) + D + c]; }
                xs[i] = sx; }
            __syncthreads();
            { const int t = tid, q = t >> 5, sl = t & 31, gate = q >> 3, jj = q & 7;
              const float* W = (gate ? gate_x_w : gate_a_w) + (size_t)h * 65536 + j0 + jj;
              float part[16];
#pragma unroll
              for (int p = 0; p < 16; ++p) part[p] = 0.f;
#pragma unroll
              for (int ii = 0; ii < 8; ++ii) { const int i = 8 * sl + ii; const float wv = W[i * 256];
#pragma unroll
                  for (int p = 0; p < 16; ++p) part[p] += xs[p * 256 + i] * wv; }
#pragma unroll
              for (int o = 1; o < 32; o <<= 1)
#pragma unroll
                  for (int p = 0; p < 16; ++p) part[p] += __shfl_xor(part[p], o);
              if (sl == 0) { const float bias = (gate ? gate_x_b : gate_a_b)[256 * h + j0 + jj];
#pragma unroll
                  for (int p = 0; p < 16; ++p) rg[q * 16 + p] = sigm(part[p] + bias); } }
            __syncthreads();
            if (tid < 16) { const int t = tid, jj = t & 7, b = t >> 3, ch = 8 * cb + jj; const float nl = NLS[ch]; float hh = 0.f;
                for (int p = 0; p < 16; ++p) { const float r = rg[jj * 16 + p], ig = rg[(8 + jj) * 16 + p], tt = expm1_neg(nl * r);
                    hh = (1.f + tt) * hh + __builtin_amdgcn_sqrtf(-tt * (2.f + tt)) * ig * xs[p * 256 + j0 + jj]; }
                float carry = hh;
                for (int k = 0; k < 64; ++k) { CARRY[(size_t)(b * 64 + k) * D + ch] = carry; carry = ab[(b * 64 + k) * 8 + jj] * carry + ab[1024 + (b * 64 + k) * 8 + jj]; } }
            __syncthreads();
        }
        run_items(N_EARLY, NITEMS);
        if (BOTH(3)) GRID_BAR();
        STAMP(4);
    }

    if (IN(4)) {
        const int gw = vcu * NWAVES + wave, NGW = G * NWAVES, ln = lane;
        for (int m0 = 4 * gw; m0 < MR; m0 += 4 * NGW) {
#pragma unroll
            for (int r = 0; r < 4; ++r) { const int m = m0 + r; const float* cr = CARRY + (size_t)(m >> 6) * D;
#pragma unroll
                for (int q = 0; q < 4; ++q) { const int c = 512 * q + 8 * ln; float a0[8], a1[8], o[8];
                    unpack8(*(const v4u*)(MBUF0 + (size_t)m * D + c), a0); unpack8(*(const v4u*)(MBUF1 + (size_t)m * D + c), a1);
                    const f32x4 c0 = *(const f32x4*)(cr + c), c1 = *(const f32x4*)(cr + c + 4);
#pragma unroll
                    for (int e = 0; e < 8; ++e) o[e] = a0[e] + a1[e] * (e < 4 ? c0[e & 3] : c1[e & 3]);
                    *(v4u*)(MBUF0 + (size_t)m * D + c) = pack8(o); } } }
        if (BOTH(4)) GRID_BAR();
        STAMP(5);
    }

    if (IN(5)) {
        { pg8::Gemm g{MBUF0, WOUT_T, D, D, 1 << 30}; pg8::StaticOrder S; S.init(MR, D, G, bx); EpiH1 E{x, out, H1BF, ROWSS1};
          RUN_GEMM(EpiH1, g, S, E); }
        if (BOTH(5)) GRID_BAR();
        STAMP(6);
    }
    if (IN(6)) {
        REP(6) { pg8::Gemm g{H1BF, W1_T, D, D, 1 << 30}; pg8::StaticOrder S; S.init(MR, DFF, G, bx); EpiAct E{ACT, ROWSS1};
          RUN_GEMM(EpiAct, g, S, E); }
        if (BOTH(6)) GRID_BAR();
        STAMP(7);
    }
    if (IN(7)) {
        { pg8::Gemm g{ACT, W2_T, DFF, DFF, 1 << 30}; pg8::StaticOrder S; S.init(MR, D, G, bx); EpiOut E{out, ROWSS2};
          RUN_GEMM(EpiOut, g, S, E); }
        if (BOTH(7)) GRID_BAR();
        STAMP(8);
    }
    if (IN(8)) {
        const int gw = vcu * NWAVES + wave, NGW = G * NWAVES;
        for (int m = gw; m < MR; m += NGW) { const float rs = rsqrtf(ROWSS2[m] * (1.f / D) + NORM_EPS); f32x4* orow = (f32x4*)(out + (size_t)m * D) + lane; const f32x4* gr = (const f32x4*)final_g + lane;
#pragma unroll
            for (int j = 0; j < 8; ++j) { f32x4 v = orow[64 * j]; const f32x4 gg = gr[64 * j]; v = v * rs * gg; orow[64 * j] = v; } }
    }
    if (MK_TS >= 0 && bx == 0 && tid == 0) { STAMP(9);
        const unsigned long long t0 = ((unsigned long long)MISC[17 + 2 * MK_TS] << 32) | MISC[16 + 2 * MK_TS], t1 = ((unsigned long long)MISC[17 + 2 * (MK_TS + 1)] << 32) | MISC[16 + 2 * (MK_TS + 1)];
        const unsigned long long te = __builtin_amdgcn_s_memrealtime(), wait = 4ull * (t1 - t0);
        while (__builtin_amdgcn_s_memrealtime() - te < wait && wait < 400000ull) __builtin_amdgcn_s_sleep(8); }
#undef IN
#undef BOTH
#undef tid
#undef lane
#undef wave
}

extern "C" void kernel_launch(void* const* d_in, const int* in_sizes, int n_in, void* d_out, int out_size, void* d_ws, size_t ws_size, hipStream_t stream) {
    static int grid = 0;
    if (grid == 0) {
        if (n_in != 18 || in_sizes[0] != MR * D || out_size != MR * D || ws_size < WS_END) { fprintf(stderr, "kernel_launch: unexpected shapes or workspace (n_in %d, ws %zu)\n", n_in, ws_size); grid = -1; return; }
        int dev = 0, cus = 0;
        if (hipGetDevice(&dev) != hipSuccess || hipDeviceGetAttribute(&cus, hipDeviceAttributeMultiprocessorCount, dev) != hipSuccess) { grid = -1; return; }
        if (hipFuncSetAttribute((const void*)fwd_kernel, hipFuncAttributeMaxDynamicSharedMemorySize, LDS_BYTES) != hipSuccess) { grid = -1; return; }
        (void)hipGetLastError();
        grid = cus;
    }
    if (grid < 0) return;
    (void)hipMemsetAsync((char*)d_ws + WS_CTL, 0, CTL_ZERO_BYTES, stream);
    Args a{};
    for (int i = 0; i < 18; ++i) a.in[i] = (const float*)d_in[i];
    a.out = (float*)d_out; a.ws = (unsigned char*)d_ws;
    if (N_LAUNCHES == 1) { a.ph_lo = 0; a.ph_hi = NPHASES; a.li = 0; hipLaunchKernelGGL(fwd_kernel, dim3(grid), dim3(NWAVES * 64), LDS_BYTES, stream, a); }
    else for (int li = 0; li < NPHASES; ++li) { a.ph_lo = li; a.ph_hi = li + 1; a.li = li; hipLaunchKernelGGL(fwd_kernel, dim3(grid), dim3(NWAVES * 64), LDS_BYTES, stream, a); }
}
```
